# Optimizing an MI355X kernel written in HIP

```python
import math
import jax, jax.numpy as jnp
from jax import lax
import numpy as np

D_MODEL = 1024
BATCH = 4
SEQ = 4096
DEPTH = 1

GMLP_CHUNK = 128
GMLP_GROUPS = 8
GMLP_WIDTH = D_MODEL
GMLP_GROUP_DIM = GMLP_WIDTH // GMLP_GROUPS
MOBA_HEADS = 8
MOBA_HEAD_DIM = 128
MOBA_WIDTH = MOBA_HEADS * MOBA_HEAD_DIM
MOBA_BLOCK = 256
MOBA_TOPK = 3
MOBA_Q_CHUNK = 32
FFN_HIDDEN = int(math.ceil(8 * D_MODEL / 3 / 256) * 256)
IN_SPLITS = (GMLP_WIDTH, GMLP_WIDTH, MOBA_WIDTH, MOBA_WIDTH, MOBA_WIDTH, D_MODEL, D_MODEL)
IN_WIDTH = sum(IN_SPLITS)
N_MOD = 6
EPS = 1e-6
NEG = -1e30

kernel_name = "hybrid_gmlp_moba_gated_block"


def _rmsnorm(x, g):
    xf = x.astype(jnp.float32)
    y = xf * lax.rsqrt(jnp.mean(xf * xf, axis=-1, keepdims=True) + EPS)
    return (y * g.astype(jnp.float32)).astype(x.dtype)


def _layernorm(x, g, b):
    xf = x.astype(jnp.float32)
    mu = jnp.mean(xf, axis=-1, keepdims=True)
    var = jnp.mean(jnp.square(xf - mu), axis=-1, keepdims=True)
    y = (xf - mu) * lax.rsqrt(var + EPS)
    return (y * g.astype(jnp.float32) + b.astype(jnp.float32)).astype(x.dtype)


def _modulate(h, shift, scale):
    return h * (1 + scale[:, None, :]) + shift[:, None, :]


def _spatial_gating(u, v, ln_g, ln_b, w_s, b_s):
    B_, S_, _ = v.shape
    v = _layernorm(v, ln_g, ln_b)
    nc = S_ // GMLP_CHUNK
    vg = v.reshape(B_, nc, GMLP_CHUNK, GMLP_GROUPS, GMLP_GROUP_DIM)
    causal = jnp.tril(jnp.ones((GMLP_CHUNK, GMLP_CHUNK), dtype=bool))
    w = w_s * causal.astype(w_s.dtype)[None]
    mixed = jnp.einsum('gts,bcsgd->bctgd', w, vg) + b_s.T[None, None, :, :, None]
    return u * mixed.reshape(B_, S_, GMLP_WIDTH)


def _moba_attention(q, k, v):
    B_, S_, H_, hd = q.shape
    bh = B_ * H_
    nb = -(-S_ // MOBA_BLOCK)
    pad = nb * MOBA_BLOCK - S_
    qh = q.transpose(0, 2, 1, 3).reshape(bh, S_, hd)
    kh = jnp.pad(k.transpose(0, 2, 1, 3).reshape(bh, S_, hd), ((0, 0), (0, pad), (0, 0)))
    vh = jnp.pad(v.transpose(0, 2, 1, 3).reshape(bh, S_, hd), ((0, 0), (0, pad), (0, 0)))
    kb = kh.reshape(bh, nb, MOBA_BLOCK, hd)
    vb = vh.reshape(bh, nb, MOBA_BLOCK, hd)
    kbar = jnp.mean(kb.astype(jnp.float32), axis=2)
    topk = min(MOBA_TOPK, nb)
    scale = hd ** -0.5
    blk_ids = jnp.arange(nb)
    gather_blocks = jax.vmap(lambda blocks, idx: blocks[idx])

    def chunk(ci):
        start = ci * MOBA_Q_CHUNK
        qc = lax.dynamic_slice_in_dim(qh, start, MOBA_Q_CHUNK, axis=1)
        t = start + jnp.arange(MOBA_Q_CHUNK)
        qblk = start // MOBA_BLOCK
        gate = jnp.einsum('nqd,nbd->nqb', qc.astype(jnp.float32), kbar)
        gate = jnp.where((blk_ids < qblk)[None, None, :], gate, NEG)
        _, idx = lax.top_k(gate, topk)
        valid = idx < qblk
        k_sel = gather_blocks(kb, idx)
        v_sel = gather_blocks(vb, idx)
        s_sel = jnp.einsum('nqd,nqjkd->nqjk', qc, k_sel).astype(jnp.float32) * scale
        s_sel = jnp.where(valid[..., None], s_sel, NEG).reshape(bh, MOBA_Q_CHUNK, topk * MOBA_BLOCK)
        k_own = lax.dynamic_slice_in_dim(kh, qblk * MOBA_BLOCK, MOBA_BLOCK, axis=1)
        v_own = lax.dynamic_slice_in_dim(vh, qblk * MOBA_BLOCK, MOBA_BLOCK, axis=1)
        s_own = jnp.einsum('nqd,nkd->nqk', qc, k_own).astype(jnp.float32) * scale
        kpos = qblk * MOBA_BLOCK + jnp.arange(MOBA_BLOCK)
        s_own = jnp.where((kpos[None, :] <= t[:, None])[None], s_own, NEG)
        p = jax.nn.softmax(jnp.concatenate([s_sel, s_own], axis=-1), axis=-1)
        p_sel = p[..., :topk * MOBA_BLOCK].reshape(bh, MOBA_Q_CHUNK, topk, MOBA_BLOCK).astype(v.dtype)
        p_own = p[..., topk * MOBA_BLOCK:].astype(v.dtype)
        return (jnp.einsum('nqjk,nqjkd->nqd', p_sel, v_sel)
                + jnp.einsum('nqk,nkd->nqd', p_own, v_own))

    out = lax.map(chunk, jnp.arange(S_ // MOBA_Q_CHUNK))
    out = out.transpose(1, 0, 2, 3).reshape(B_, H_, S_, hd).transpose(0, 2, 1, 3)
    return out.reshape(B_, S_, H_ * hd)


def setup_inputs(seed: int = 0) -> dict:
    key = jax.random.key(seed)
    ks = jax.random.split(key, 20)
    f32 = jnp.float32
    L, D = DEPTH, D_MODEL
    nrm = lambda k, shape, s: (jax.random.normal(k, shape, f32) * s)
    return {
        "x": nrm(ks[0], (BATCH, SEQ, D), 1.0),
        "c": nrm(ks[1], (BATCH, D), 1.0),
        "w_ada": nrm(ks[2], (L, D, N_MOD * D), 0.5 * D ** -0.5),
        "b_ada": nrm(ks[3], (L, N_MOD * D), 0.01),
        "norm_mix_g": 1.0 + nrm(ks[4], (L, D), 0.02),
        "w_in": nrm(ks[5], (L, D, IN_WIDTH), D ** -0.5),
        "ln_v_g": 1.0 + nrm(ks[6], (L, GMLP_WIDTH), 0.02),
        "ln_v_b": nrm(ks[7], (L, GMLP_WIDTH), 0.01),
        "w_spatial": nrm(ks[8], (L, GMLP_GROUPS, GMLP_CHUNK, GMLP_CHUNK), GMLP_CHUNK ** -0.5),
        "b_spatial": 1.0 + nrm(ks[9], (L, GMLP_GROUPS, GMLP_CHUNK), 0.01),
        "w_proj_a": nrm(ks[10], (L, GMLP_WIDTH, D), GMLP_WIDTH ** -0.5),
        "w_proj_b": nrm(ks[11], (L, MOBA_WIDTH, D), MOBA_WIDTH ** -0.5),
        "w_out": nrm(ks[12], (L, D, D), D ** -0.5),
        "norm_ffn_g": 1.0 + nrm(ks[13], (L, D), 0.02),
        "w_ffn_gate": nrm(ks[14], (L, D, FFN_HIDDEN), D ** -0.5),
        "w_ffn_up": nrm(ks[15], (L, D, FFN_HIDDEN), D ** -0.5),
        "w_ffn_down": nrm(ks[16], (L, FFN_HIDDEN, D), FFN_HIDDEN ** -0.5),
        "norm_final_g": 1.0 + nrm(ks[17], (D,), 0.02),
    }


def reference(x, c, w_ada, b_ada, norm_mix_g, w_in, ln_v_g, ln_v_b, w_spatial, b_spatial,
              w_proj_a, w_proj_b, w_out, norm_ffn_g, w_ffn_gate, w_ffn_up, w_ffn_down,
              norm_final_g):
    B_, S_, D = x.shape
    split_pts = list(np.cumsum(IN_SPLITS)[:-1])
    c_act = jax.nn.silu(c)
    for l in range(DEPTH):
        mod = c_act @ w_ada[l] + b_ada[l]
        sh_m, sc_m, g_m, sh_f, sc_f, g_f = jnp.split(mod, N_MOD, axis=-1)

        h = _modulate(_rmsnorm(x, norm_mix_g[l]), sh_m, sc_m)
        proj = h @ w_in[l]
        uv_u, uv_v, q, k, v, gate_a, gate_b = jnp.split(proj, split_pts, axis=-1)
        y_a = _spatial_gating(jax.nn.gelu(uv_u), jax.nn.gelu(uv_v),
                              ln_v_g[l], ln_v_b[l], w_spatial[l], b_spatial[l])
        y_b = _moba_attention(q.reshape(B_, S_, MOBA_HEADS, MOBA_HEAD_DIM),
                              k.reshape(B_, S_, MOBA_HEADS, MOBA_HEAD_DIM),
                              v.reshape(B_, S_, MOBA_HEADS, MOBA_HEAD_DIM))
        merged = (jax.nn.sigmoid(gate_a) * (y_a @ w_proj_a[l])
                  + jax.nn.sigmoid(gate_b) * (y_b @ w_proj_b[l]))
        x = x + g_m[:, None, :] * (merged @ w_out[l])

        h = _modulate(_rmsnorm(x, norm_ffn_g[l]), sh_f, sc_f)
        ff = (jax.nn.silu(h @ w_ffn_gate[l]) * (h @ w_ffn_up[l])) @ w_ffn_down[l]
        x = x + g_f[:, None, :] * ff
    return _rmsnorm(x, norm_final_g)
```

```cpp
#include <hip/hip_runtime.h>
#include <hip/hip_cooperative_groups.h>
#include <cstdio>
#include <cstdint>
namespace cg = cooperative_groups;

#define LAS __attribute__((address_space(3)))
typedef unsigned short bf16_t;
typedef short bf16x8 __attribute__((ext_vector_type(8)));
typedef short s16x4 __attribute__((ext_vector_type(4)));
typedef float f32x4 __attribute__((ext_vector_type(4)));
typedef float f32x2 __attribute__((ext_vector_type(2)));
typedef float f32x16 __attribute__((ext_vector_type(16)));
typedef unsigned u32x4 __attribute__((ext_vector_type(4)));
typedef unsigned u32x2 __attribute__((ext_vector_type(2)));

#ifndef MK_N_LAUNCHES
#define MK_N_LAUNCHES 1
#endif

constexpr int D_MODEL = 1024, BATCH = 4, SEQ = 4096, M_TOK = BATCH * SEQ;
constexpr int IN_WIDTH = 7168, FFN_H = 2816, N_MOD6 = 6 * D_MODEL;
constexpr float EPS = 1e-6f;
constexpr float QSCALE = 0.08838834764831845f * 1.4426950408889634f;
constexpr float NEGB = -1.0e30f;

__device__ __forceinline__ unsigned cvt_pk_bf16(float lo, float hi) { unsigned r; asm volatile("v_cvt_pk_bf16_f32 %0, %1, %2" : "=v"(r) : "v"(lo), "v"(hi)); return r; }
__device__ __forceinline__ float bf_lo(unsigned w) { return __uint_as_float(w << 16); }
__device__ __forceinline__ float bf_hi(unsigned w) { return __uint_as_float(w & 0xffff0000u); }
__device__ __forceinline__ float wave_sum(float v) {
#pragma unroll
    for (int o = 1; o < 64; o <<= 1) v += __shfl_xor(v, o);
    return v;
}
__device__ __forceinline__ int fresh_tid() { int t = threadIdx.x; asm volatile("" : "+v"(t)); return t; }
__device__ __forceinline__ float fast_rcp(float x) { return __builtin_amdgcn_rcpf(x); }
__device__ __forceinline__ float fast_exp2(float x) { return __builtin_amdgcn_exp2f(x); }

namespace pg8 {
constexpr int BM = 256, BK = 64, HALF = 128, HTB = HALF * BK * 2, STAGE_BYTES = 8 * HTB, NXCD = 8, WGM = 8;
__host__ __device__ __forceinline__ int lds_byte(int r, int c) { const int st = (r >> 4) * 2 + (c >> 5), rr = r & 15, cc = c & 31, ob = rr * 64 + cc * 2; return st * 1024 + (ob ^ (((ob >> 9) & 1) << 5)); }
__host__ __device__ __forceinline__ void stage_rc(int b, int& R, int& C) { const int st = b / 1024, sb = b % 1024, swz = sb ^ (((sb >> 9) & 1) << 5); R = (st >> 1) * 16 + swz / 64; C = (st & 1) * 32 + (swz % 64) / 2; }
__host__ __device__ __forceinline__ int perm32(int rho) { const int n = rho >> 4, i = rho & 15; return 8 * (i >> 2) + 4 * n + (i & 3); }

struct Unit { int pm, pn; };
struct Gemm { const bf16_t* A; const bf16_t* Bt; int M, N, K; };

struct StaticOrder {
    int nM, nN, nwg, G, c;
    __device__ void init(int M, int N, int G_, int c_) { nM = M / BM; nN = N / BM; nwg = nM * nN; G = G_; c = c_; }
    __device__ bool next(int i, Unit& u) const {
        const long L = (long)i * G + c; if (L >= nwg) return false;
        int wgid = (int)L; { const int q = nwg / NXCD, r = nwg % NXCD, xcd = wgid % NXCD, off = wgid / NXCD; wgid = (xcd < r ? xcd * (q + 1) : r * (q + 1) + (xcd - r) * q) + off; }
        const int nig = WGM * nN, gid = wgid / nig, fm = gid * WGM, gsz = (nM - fm) < WGM ? (nM - fm) : WGM;
        u.pm = fm + ((wgid % nig) % gsz); u.pn = (wgid % nig) / gsz; return true;
    }
};

typedef f32x4 Acc[2][2][4][2];

struct EpiIn {
    static constexpr bool PERM = true, HAS_MID = false;
    bf16_t* ycat; bf16_t* v1; bf16_t* kb; bf16_t* vv; bf16_t* ga; bf16_t* gb; float* kpart;
    __device__ __forceinline__ void mid(Acc&, const Unit&, int, int, int, int) const {}
    __device__ __forceinline__ void operator()(Acc& acc, const Unit& u, int wr, int wc, int fr, int fq) const {
        asm volatile("" : "+v"(fr), "+v"(fq));
        const int sec = u.pn >> 2, colt = (u.pn & 3) * BM;
        bf16_t* base; int ldc = 1024; bool sig = false, usex = false; float k1 = 0.f, k3 = 0.f, lin = 1.f;
        if (sec == 0) { base = ycat; ldc = 2048; sig = true; usex = true; k1 = 2.3022082f; k3 = 0.10294324f; }
        else if (sec == 1) { base = v1; sig = true; usex = true; k1 = 2.3022082f; k3 = 0.10294324f; }
        else if (sec == 2) { base = ycat + 1024; ldc = 2048; lin = QSCALE; }
        else if (sec == 3) { base = kb; }
        else if (sec == 4) { base = vv; }
        else if (sec == 5) { base = ga; sig = true; k1 = 1.4426950409f; }
        else { base = gb; sig = true; k1 = 1.4426950409f; }
        if (sec == 3) {
#pragma unroll
            for (int bj = 0; bj < 2; ++bj)
#pragma unroll
                for (int n = 0; n < 2; ++n) {
                    f32x4 s = (f32x4){0.f, 0.f, 0.f, 0.f};
#pragma unroll
                    for (int ai = 0; ai < 2; ++ai)
#pragma unroll
                        for (int m = 0; m < 4; ++m) s += acc[ai][bj][m][n];
#pragma unroll
                    for (int o = 1; o < 16; o <<= 1) { s[0] += __shfl_xor(s[0], o); s[1] += __shfl_xor(s[1], o); s[2] += __shfl_xor(s[2], o); s[3] += __shfl_xor(s[3], o); }
                    if (fr == 0) *(f32x4*)(kpart + (size_t)(u.pm * 2 + wr) * 1024 + colt + bj * HALF + wc * 32 + 8 * fq + 4 * n) = s;
                }
        }
        const int row0 = u.pm * BM + wr * 64 + fr, col0 = colt + wc * 32 + 8 * fq;
#pragma unroll
        for (int ai = 0; ai < 2; ++ai)
#pragma unroll
            for (int m = 0; m < 4; ++m) { bf16_t* rowp = base + (size_t)(row0 + ai * HALF + m * 16) * ldc + col0;
#pragma unroll
                for (int bj = 0; bj < 2; ++bj) { f32x4 v0 = acc[ai][bj][m][0], v1_ = acc[ai][bj][m][1];
                    if (sig) {
#pragma unroll
                        for (int i = 0; i < 4; ++i) {
                            { const float x = v0[i], z = x * (k1 + k3 * x * x), s = fast_rcp(1.f + fast_exp2(-z)); v0[i] = usex ? x * s : s; }
                            { const float x = v1_[i], z = x * (k1 + k3 * x * x), s = fast_rcp(1.f + fast_exp2(-z)); v1_[i] = usex ? x * s : s; }
                        }
                    } else { v0 = v0 * lin; v1_ = v1_ * lin; }
                    u32x4 w; w.x = cvt_pk_bf16(v0[0], v0[1]); w.y = cvt_pk_bf16(v0[2], v0[3]); w.z = cvt_pk_bf16(v1_[0], v1_[1]); w.w = cvt_pk_bf16(v1_[2], v1_[3]);
                    *(u32x4*)(rowp + bj * HALF) = w; } }
    }
};

struct EpiMerged {
    static constexpr bool PERM = true, HAS_MID = true;
    const bf16_t* ga; const bf16_t* gb; bf16_t* out;
    __device__ __forceinline__ void mid(Acc& acc, const Unit& u, int wr, int wc, int fr, int fq) const {
        asm volatile("" : "+v"(fr), "+v"(fq));
        const int row0 = u.pm * BM + wr * 64 + fr, col0 = u.pn * BM + wc * 32 + 8 * fq;
#pragma unroll
        for (int ai = 0; ai < 2; ++ai)
#pragma unroll
            for (int m = 0; m < 4; ++m) { const size_t off = (size_t)(row0 + ai * HALF + m * 16) * 1024 + col0;
#pragma unroll
                for (int bj = 0; bj < 2; ++bj) { const u32x4 a = *(const u32x4*)(ga + off + bj * HALF), b = *(const u32x4*)(gb + off + bj * HALF);
                    f32x4 r0, r1;
                    r0[0] = bf_lo(a.x) * fast_rcp(bf_lo(b.x)); r0[1] = bf_hi(a.x) * fast_rcp(bf_hi(b.x)); r0[2] = bf_lo(a.y) * fast_rcp(bf_lo(b.y)); r0[3] = bf_hi(a.y) * fast_rcp(bf_hi(b.y));
                    r1[0] = bf_lo(a.z) * fast_rcp(bf_lo(b.z)); r1[1] = bf_hi(a.z) * fast_rcp(bf_hi(b.z)); r1[2] = bf_lo(a.w) * fast_rcp(bf_lo(b.w)); r1[3] = bf_hi(a.w) * fast_rcp(bf_hi(b.w));
                    acc[ai][bj][m][0] *= r0; acc[ai][bj][m][1] *= r1; }
                asm volatile("" : "+v"(acc[ai][0][m][0]), "+v"(acc[ai][0][m][1]), "+v"(acc[ai][1][m][0]), "+v"(acc[ai][1][m][1]));
                asm volatile("" ::: "memory"); }
    }
    __device__ __forceinline__ void operator()(Acc& acc, const Unit& u, int wr, int wc, int fr, int fq) const {
        asm volatile("" : "+v"(fr), "+v"(fq));
        const int row0 = u.pm * BM + wr * 64 + fr, col0 = u.pn * BM + wc * 32 + 8 * fq;
#pragma unroll
        for (int ai = 0; ai < 2; ++ai)
#pragma unroll
            for (int m = 0; m < 4; ++m) { const size_t off = (size_t)(row0 + ai * HALF + m * 16) * 1024 + col0;
#pragma unroll
                for (int bj = 0; bj < 2; ++bj) { const u32x4 b = *(const u32x4*)(gb + off + bj * HALF);
                    const f32x4 v0 = acc[ai][bj][m][0], v1_ = acc[ai][bj][m][1];
                    u32x4 w; w.x = cvt_pk_bf16(v0[0] * bf_lo(b.x), v0[1] * bf_hi(b.x)); w.y = cvt_pk_bf16(v0[2] * bf_lo(b.y), v0[3] * bf_hi(b.y));
                    w.z = cvt_pk_bf16(v1_[0] * bf_lo(b.z), v1_[1] * bf_hi(b.z)); w.w = cvt_pk_bf16(v1_[2] * bf_lo(b.w), v1_[3] * bf_hi(b.w));
                    *(u32x4*)(out + off + bj * HALF) = w; } }
    }
};

struct EpiResid {
    static constexpr bool PERM = false, HAS_MID = false;
    const float* base; float* out; const float* gvec;
    __device__ __forceinline__ void mid(Acc&, const Unit&, int, int, int, int) const {}
    __device__ __forceinline__ void operator()(Acc& acc, const Unit& u, int wr, int wc, int fr, int fq) const {
        asm volatile("" : "+v"(fr), "+v"(fq));
        const int bidx = (u.pm * BM) / SEQ; const float* gv = gvec + (size_t)bidx * N_MOD6;
        const int row0 = u.pm * BM + wr * 64 + fr, col0 = u.pn * BM + wc * 32 + 4 * fq;
        f32x4 g4[2][2];
#pragma unroll
        for (int bj = 0; bj < 2; ++bj)
#pragma unroll
            for (int n = 0; n < 2; ++n) g4[bj][n] = *(const f32x4*)(gv + col0 + bj * HALF + n * 16);
#pragma unroll
        for (int ai = 0; ai < 2; ++ai)
#pragma unroll
            for (int m = 0; m < 4; ++m) { const size_t off = (size_t)(row0 + ai * HALF + m * 16) * 1024 + col0;
#pragma unroll
                for (int bj = 0; bj < 2; ++bj)
#pragma unroll
                    for (int n = 0; n < 2; ++n) { const f32x4 bs = *(const f32x4*)(base + off + bj * HALF + n * 16);
                        *(f32x4*)(out + off + bj * HALF + n * 16) = bs + g4[bj][n] * acc[ai][bj][m][n]; } }
    }
};

struct EpiSwiglu {
    static constexpr bool PERM = true, HAS_MID = false;
    bf16_t* out;
    __device__ __forceinline__ void mid(Acc&, const Unit&, int, int, int, int) const {}
    __device__ __forceinline__ void operator()(Acc& acc, const Unit& u, int wr, int wc, int fr, int fq) const {
        asm volatile("" : "+v"(fr), "+v"(fq));
        const int row0 = u.pm * BM + wr * 64 + fr, col0 = u.pn * HALF + wc * 32 + 8 * fq;
#pragma unroll
        for (int ai = 0; ai < 2; ++ai)
#pragma unroll
            for (int m = 0; m < 4; ++m) { bf16_t* rowp = out + (size_t)(row0 + ai * HALF + m * 16) * FFN_H + col0;
                float r[8];
#pragma unroll
                for (int n = 0; n < 2; ++n)
#pragma unroll
                    for (int i = 0; i < 4; ++i) { const float g = acc[ai][0][m][n][i], up = acc[ai][1][m][n][i];
                        r[4 * n + i] = g * fast_rcp(1.f + fast_exp2(-1.4426950409f * g)) * up; }
                u32x4 w; w.x = cvt_pk_bf16(r[0], r[1]); w.y = cvt_pk_bf16(r[2], r[3]); w.z = cvt_pk_bf16(r[4], r[5]); w.w = cvt_pk_bf16(r[6], r[7]);
                *(u32x4*)rowp = w; }
    }
};

template <class Epi, class Sched, bool ALIGN_EPI, bool SP2>
__device__ __forceinline__ void gemm_phase(LAS unsigned char* lds, const Gemm g, const Sched& S, const Epi& E) {
    const int tid = fresh_tid(), wid = __builtin_amdgcn_readfirstlane(tid >> 6), lane = tid & 63, wr = wid >> 2, wc = wid & 3, fr = lane & 15, fq = lane >> 4;
    const int K = g.K, nt = K / BK;
    unsigned voffA[2], voffB[2];
#pragma unroll
    for (int i = 0; i < 2; ++i) { int R, C; stage_rc(tid * 16 + i * 8192, R, C); const int Rb = Epi::PERM ? ((R & ~31) + perm32(R & 31)) : R;
        voffA[i] = (unsigned)(R * K + C) * 2u; voffB[i] = (unsigned)(Rb * K + C) * 2u; }
    const size_t kstep = (size_t)(BK * 2);
    const size_t hstep = (size_t)HALF * K * 2;
    const size_t tstep = 2 * hstep;
    const unsigned ldsw = (unsigned)wid * 1024u;
    const int aoff = lds_byte(wr * 64 + fr, fq * 8), boff = lds_byte(wc * 32 + fr, fq * 8);
#define PG8_SA(b, h) (((b) * 2 + (h)) * HTB)
#define PG8_SB(b, h) ((4 + (b) * 2 + (h)) * HTB)
#define PG8_STAGE(bufoff, gbase, voff) do { _Pragma("unroll") for (int _i = 0; _i < 2; ++_i) \
        __builtin_amdgcn_global_load_lds((const unsigned*)((const char*)(gbase) + (voff)[_i]), (LAS unsigned*)(lds + (bufoff) + ldsw + _i * 8192), 16, 0, 0); } while (0)
#define PG8_LDA(dst, b, h) do { _Pragma("unroll") for (int m = 0; m < 4; ++m) _Pragma("unroll") for (int k = 0; k < 2; ++k) dst[m][k] = *(const LAS bf16x8*)(lds + PG8_SA(b, h) + aoff + m * 2048 + k * 1024); } while (0)
#define PG8_LDB(dst, b, h) do { _Pragma("unroll") for (int n = 0; n < 2; ++n) _Pragma("unroll") for (int k = 0; k < 2; ++k) dst[n][k] = *(const LAS bf16x8*)(lds + PG8_SB(b, h) + boff + n * 2048 + k * 1024); } while (0)
#define PG8_MMA(ai, bj, At, Bt) do { __builtin_amdgcn_s_setprio(1); _Pragma("unroll") for (int m = 0; m < 4; ++m) _Pragma("unroll") for (int n = 0; n < 2; ++n) _Pragma("unroll") for (int k = 0; k < 2; ++k) \
        acc[ai][bj][m][n] = __builtin_amdgcn_mfma_f32_16x16x32_bf16(Bt[n][k], At[m][k], acc[ai][bj][m][n], 0, 0, 0); __builtin_amdgcn_s_setprio(0); } while (0)
#define PG8_WAIT_V(n) asm volatile("s_waitcnt vmcnt(" #n ")" ::: "memory")
#define PG8_WAIT_L(n) asm volatile("s_waitcnt lgkmcnt(" #n ")" ::: "memory")
#define PG8_BAR __builtin_amdgcn_s_barrier()
#define PG8_SCHED __builtin_amdgcn_sched_barrier(0)
    Unit cur, nxt; int ui = 0;
    if (!S.next(0, cur)) return;
    Acc acc;
#pragma unroll
    for (int a = 0; a < 2; ++a)
#pragma unroll
        for (int b = 0; b < 2; ++b)
#pragma unroll
            for (int m = 0; m < 4; ++m)
#pragma unroll
                for (int n = 0; n < 2; ++n) acc[a][b][m][n] = (f32x4){0.f, 0.f, 0.f, 0.f};
    bf16x8 At[4][2], B0[2][2], B1[2][2];
    const char* cA = (const char*)g.A + (size_t)cur.pm * tstep; const char* cB = (const char*)g.Bt + (size_t)cur.pn * tstep;
    if constexpr (SP2) {
        PG8_STAGE(PG8_SB(0, 0), cB, voffB); PG8_STAGE(PG8_SB(0, 1), cB + hstep, voffB); PG8_STAGE(PG8_SA(0, 0), cA, voffA); PG8_STAGE(PG8_SA(0, 1), cA + hstep, voffA);
        if (wr == 1) PG8_BAR;
        PG8_WAIT_V(2); PG8_BAR;
        PG8_STAGE(PG8_SB(1, 0), cB + kstep, voffB); PG8_STAGE(PG8_SA(1, 0), cA + kstep, voffA); PG8_STAGE(PG8_SB(1, 1), cB + hstep + kstep, voffB);
        PG8_WAIT_V(6); PG8_BAR;
    } else {
        PG8_STAGE(PG8_SB(0, 0), cB, voffB); PG8_STAGE(PG8_SA(0, 0), cA, voffA); PG8_STAGE(PG8_SB(0, 1), cB + hstep, voffB); PG8_STAGE(PG8_SA(0, 1), cA + hstep, voffA);
        if (wr == 1) PG8_BAR;
        PG8_WAIT_V(4); PG8_BAR;
        PG8_STAGE(PG8_SB(1, 0), cB + kstep, voffB); PG8_STAGE(PG8_SA(1, 0), cA + kstep, voffA); PG8_STAGE(PG8_SB(1, 1), cB + hstep + kstep, voffB);
        PG8_WAIT_V(6); PG8_BAR;
    }
    for (;;) {
        const bool has_next = S.next(ui + 1, nxt);
        const char* nA = has_next ? (const char*)g.A + (size_t)nxt.pm * tstep : cA; const char* nB = has_next ? (const char*)g.Bt + (size_t)nxt.pn * tstep : cB;
        for (int t = 0; t < nt; t += 2) {
            if constexpr (Epi::HAS_MID) { if (t == (nt >> 1)) E.mid(acc, cur, wr, wc, fr, fq); }
            const bool last = (t == nt - 2);
            const char* a1 = cA + (size_t)(t + 1) * kstep;
            const char* a2 = last ? nA : cA + (size_t)(t + 2) * kstep; const char* b2 = last ? nB : cB + (size_t)(t + 2) * kstep;
            const char* a3 = a2 + kstep; const char* b3 = b2 + kstep;
            if constexpr (SP2) {
            PG8_LDB(B0, 0, 0); PG8_LDB(B1, 0, 1); PG8_SCHED; PG8_LDA(At, 0, 0); PG8_STAGE(PG8_SA(1, 1), a1 + hstep, voffA);
            PG8_WAIT_V(8); PG8_WAIT_L(0); PG8_BAR; PG8_MMA(0, 0, At, B0); PG8_MMA(0, 1, At, B1); PG8_BAR; PG8_SCHED;
            PG8_LDA(At, 0, 1); PG8_STAGE(PG8_SB(0, 0), b2, voffB); PG8_STAGE(PG8_SB(0, 1), b2 + hstep, voffB); PG8_STAGE(PG8_SA(0, 0), a2, voffA);
            PG8_WAIT_V(8); PG8_WAIT_L(0); PG8_BAR; PG8_MMA(1, 0, At, B0); PG8_MMA(1, 1, At, B1); PG8_BAR; PG8_SCHED;
            PG8_LDB(B0, 1, 0); PG8_LDB(B1, 1, 1); PG8_SCHED; PG8_LDA(At, 1, 0); PG8_STAGE(PG8_SA(0, 1), a2 + hstep, voffA);
            PG8_WAIT_V(8); PG8_WAIT_L(0); PG8_BAR; PG8_MMA(0, 0, At, B0); PG8_MMA(0, 1, At, B1); PG8_BAR; PG8_SCHED;
            PG8_LDA(At, 1, 1); PG8_STAGE(PG8_SB(1, 0), b3, voffB); PG8_STAGE(PG8_SB(1, 1), b3 + hstep, voffB); PG8_STAGE(PG8_SA(1, 0), a3, voffA);
            PG8_WAIT_V(8); PG8_WAIT_L(0); PG8_BAR; PG8_MMA(1, 0, At, B0); PG8_MMA(1, 1, At, B1); PG8_BAR; PG8_SCHED;
            } else {
            PG8_LDB(B0, 0, 0); PG8_SCHED; PG8_LDA(At, 0, 0); PG8_STAGE(PG8_SA(1, 1), a1 + hstep, voffA);
            PG8_WAIT_L(8); PG8_BAR; PG8_WAIT_L(0); PG8_MMA(0, 0, At, B0); PG8_BAR; PG8_SCHED;
            PG8_LDB(B1, 0, 1); PG8_STAGE(PG8_SB(0, 0), b2, voffB);
            PG8_BAR; PG8_WAIT_L(0); PG8_MMA(0, 1, At, B1); PG8_BAR;
            PG8_LDA(At, 0, 1); PG8_STAGE(PG8_SA(0, 0), a2, voffA);
            PG8_BAR; PG8_WAIT_L(0); PG8_MMA(1, 0, At, B0); PG8_BAR; PG8_SCHED;
            PG8_STAGE(PG8_SB(0, 1), b2 + hstep, voffB);
            PG8_WAIT_V(6); PG8_BAR; PG8_MMA(1, 1, At, B1); PG8_BAR;
            PG8_LDB(B0, 1, 0); PG8_SCHED; PG8_LDA(At, 1, 0); PG8_STAGE(PG8_SA(0, 1), a2 + hstep, voffA);
            PG8_WAIT_L(8); PG8_BAR; PG8_WAIT_L(0); PG8_MMA(0, 0, At, B0); PG8_BAR; PG8_SCHED;
            PG8_LDB(B1, 1, 1); PG8_STAGE(PG8_SB(1, 0), b3, voffB);
            PG8_BAR; PG8_WAIT_L(0); PG8_MMA(0, 1, At, B1); PG8_BAR;
            PG8_LDA(At, 1, 1); PG8_STAGE(PG8_SA(1, 0), a3, voffA);
            PG8_BAR; PG8_WAIT_L(0); PG8_MMA(1, 0, At, B0); PG8_BAR; PG8_SCHED;
            PG8_STAGE(PG8_SB(1, 1), b3 + hstep, voffB);
            PG8_WAIT_V(6); PG8_BAR; PG8_MMA(1, 1, At, B1); PG8_BAR;
            }
        }
        if constexpr (ALIGN_EPI) { if (wr == 0) PG8_BAR; }
        E(acc, cur, wr, wc, fr, fq);
        if (!has_next) break;
#pragma unroll
        for (int a = 0; a < 2; ++a)
#pragma unroll
            for (int b = 0; b < 2; ++b)
#pragma unroll
                for (int m = 0; m < 4; ++m)
#pragma unroll
                    for (int n = 0; n < 2; ++n) acc[a][b][m][n] = (f32x4){0.f, 0.f, 0.f, 0.f};
        cur = nxt; cA = nA; cB = nB; ++ui;
        if constexpr (ALIGN_EPI) { if (wr == 1) PG8_BAR; }
    }
    PG8_WAIT_V(0);
    if constexpr (!ALIGN_EPI) { if (wr == 0) PG8_BAR; }
    PG8_BAR;
#undef PG8_SA
#undef PG8_SB
#undef PG8_STAGE
#undef PG8_LDA
#undef PG8_LDB
#undef PG8_MMA
#undef PG8_WAIT_V
#undef PG8_WAIT_L
#undef PG8_BAR
#undef PG8_SCHED
}
}

constexpr size_t MiB = 1u << 20;
constexpr size_t WS_MODP = 0;
constexpr size_t WS_MODF = 1536 * 1024;
constexpr size_t WS_KPART = WS_MODF + 128 * 1024;
constexpr size_t WS_WSP = WS_KPART + 512 * 1024;
constexpr size_t WS_WIN = 3 * MiB;
constexpr size_t WS_WAB = 17 * MiB;
constexpr size_t WS_WOUT = 21 * MiB;
constexpr size_t WS_WGU = 23 * MiB;
constexpr size_t WS_WD = 34 * MiB;
constexpr size_t WS_H = 40 * MiB;
constexpr size_t WS_YCAT = 72 * MiB;
constexpr size_t WS_K = 136 * MiB;
constexpr size_t WS_VV = 168 * MiB;
constexpr size_t WS_V1 = 200 * MiB;
constexpr size_t WS_END = 232 * MiB;
static_assert(WS_WSP + 256 * 1024 <= WS_WIN && WS_WD + (size_t)1024 * 2816 * 2 <= WS_H && WS_YCAT + (size_t)M_TOK * FFN_H * 2 <= WS_VV, "ws map");

constexpr int LDS_BYTES = 147456;
constexpr int NPHASE = 10;

__device__ __forceinline__ void p0_transpose_item(const float* W, int N, bf16_t* WT, int dpitch, int dkoff, int drow0, int kb, int nb, LAS float* scr, int lane) {
    const int k0 = 64 * kb, n0 = 32 * nb;
#pragma unroll 8
    for (int i = 0; i < 32; ++i) { const int kk = 2 * i + (lane >> 5); scr[kk * 33 + (lane & 31)] = W[(size_t)(k0 + kk) * N + n0 + (lane & 31)]; }
    asm volatile("s_waitcnt lgkmcnt(0)" ::: "memory");
    const int c = lane & 7;
#pragma unroll
    for (int j = 0; j < 4; ++j) { const int n = (lane >> 3) + 8 * j; const LAS float* s = scr + (8 * c) * 33 + n;
        u32x4 o; o.x = cvt_pk_bf16(s[0 * 33], s[1 * 33]); o.y = cvt_pk_bf16(s[2 * 33], s[3 * 33]); o.z = cvt_pk_bf16(s[4 * 33], s[5 * 33]); o.w = cvt_pk_bf16(s[6 * 33], s[7 * 33]);
        *(u32x4*)(WT + (size_t)(drow0 + n) * dpitch + dkoff + k0 + 8 * c) = o; }
    asm volatile("s_waitcnt lgkmcnt(0)" ::: "memory");
}

template <bool OUT_BF16>
__device__ __forceinline__ void rms_row(const float* xrow, const LAS float* Av, const LAS float* Bv, void* orow, int lane) {
    const f32x4* xr = (const f32x4*)xrow + lane;
    f32x4 v[4]; float s = 0.f;
#pragma unroll
    for (int j = 0; j < 4; ++j) { v[j] = xr[64 * j]; s += (v[j].x * v[j].x + v[j].y * v[j].y) + (v[j].z * v[j].z + v[j].w * v[j].w); }
    const float rstd = 1.0f / sqrtf(wave_sum(s) * (1.f / D_MODEL) + EPS);
#pragma unroll
    for (int j = 0; j < 4; ++j) {
        const f32x4 a = *(const LAS f32x4*)(Av + 4 * lane + 256 * j); f32x4 y = v[j] * rstd * a;
        if (Bv) y += *(const LAS f32x4*)(Bv + 4 * lane + 256 * j);
        if (OUT_BF16) { u32x2 w; w.x = cvt_pk_bf16(y.x, y.y); w.y = cvt_pk_bf16(y.z, y.w); *((u32x2*)orow + lane + 64 * j) = w; }
        else *((f32x4*)orow + lane + 64 * j) = y;
    }
}

__device__ __forceinline__ unsigned off_b(unsigned row, unsigned ch) { return 256u * row + 16u * (ch ^ (((row & 3u) << 2) | ((row >> 2) & 3u))); }
__device__ __forceinline__ unsigned tr_addr(unsigned lane, unsigned c, unsigned ks, unsigned t) {
    const unsigned h = lane >> 5, blk = (lane >> 4) & 1, q = (lane & 15) >> 2, p = lane & 3;
    return off_b(16 * ks + 8 * h + 4 * t + q, 4 * c + 2 * blk + (p >> 1)) + 8 * (p & 1);
}
__device__ __forceinline__ s16x4 tr_read(const LAS unsigned char* p) { return __builtin_bit_cast(s16x4, __builtin_amdgcn_ds_read_tr16_b64_v4i16((LAS s16x4*)p)); }
__device__ __forceinline__ bf16x8 tr_pair(const LAS unsigned char* base, unsigned lane, unsigned c, unsigned ks) {
    const s16x4 lo = tr_read(base + tr_addr(lane, c, ks, 0)), hi = tr_read(base + tr_addr(lane, c, ks, 1));
    return (bf16x8){lo[0], lo[1], lo[2], lo[3], hi[0], hi[1], hi[2], hi[3]};
}

__device__ __forceinline__ void attn_unit(LAS unsigned char* lds, int b, int h, int qblk, bf16_t* ycat, const bf16_t* Kb, const bf16_t* Vb, const float* kpart) {
    const int tid = fresh_tid(), lane = tid & 63, w = __builtin_amdgcn_readfirstlane(tid >> 6), q = lane & 31, hi = lane >> 5;
    const size_t rowbase = (size_t)b * SEQ;
    LAS float* kbar = (LAS float*)(lds + 65536);
    const unsigned qoff = (unsigned)((rowbase + (size_t)qblk * 256 + 32 * w + q) * 2048 + 1024 + h * 128);
#define Qp (ycat + qoff)
    bf16x8 qr[8];
#pragma unroll
    for (int s = 0; s < 8; ++s) qr[s] = *(const bf16x8*)(Qp + 16 * s + 8 * hi);
    for (int idx = tid; idx < qblk * 128; idx += 512) { const int j = idx >> 7, d = idx & 127; const float* kp = kpart + (size_t)((b * 16 + j) * 2) * 1024 + h * 128 + d; kbar[idx] = (kp[0] + kp[1024]) * (1.f / 256.f); }
    __syncthreads();
    float t1 = -3.0e38f, t2 = -3.0e38f, t3 = -3.0e38f; unsigned b1 = 0u, b2 = 0u, b3 = 0u;
#pragma unroll 1
    for (int j = 0; j < qblk; ++j) {
        float s0 = 0.f, s1 = 0.f;
#pragma unroll
        for (int s = 0; s < 8; ++s) {
            const f32x4 k0 = *(const LAS f32x4*)(kbar + j * 128 + 16 * s + 8 * hi), k1 = *(const LAS f32x4*)(kbar + j * 128 + 16 * s + 8 * hi + 4);
            const u32x4 qw = __builtin_bit_cast(u32x4, qr[s]);
            s0 += bf_lo(qw.x) * k0[0]; s1 += bf_hi(qw.x) * k0[1]; s0 += bf_lo(qw.y) * k0[2]; s1 += bf_hi(qw.y) * k0[3];
            s0 += bf_lo(qw.z) * k1[0]; s1 += bf_hi(qw.z) * k1[1]; s0 += bf_lo(qw.w) * k1[2]; s1 += bf_hi(qw.w) * k1[3];
        }
        const float part = s0 + s1;
        const float gj = part + __shfl_xor(part, 32);
        const unsigned bj = 1u << j;
        const bool c1 = gj > t1, c2 = gj > t2, c3 = gj > t3;
        t3 = c2 ? t2 : (c3 ? gj : t3); b3 = c2 ? b2 : (c3 ? bj : b3);
        t2 = c1 ? t1 : (c2 ? gj : t2); b2 = c1 ? b1 : (c2 ? bj : b2);
        t1 = c1 ? gj : t1;             b1 = c1 ? bj : b1;
    }
    const unsigned sel = b1 | b2 | b3;
    const int srow = tid >> 3, sch = (tid & 7) * 2;
    const unsigned st_off0 = (unsigned)(srow >> 5) * 8192u + off_b(srow & 31, sch), st_off1 = (unsigned)(srow >> 5) * 8192u + off_b(srow & 31, sch + 1);
    const unsigned kvoff = (unsigned)((rowbase + srow) * 1024 + h * 128 + sch * 8);
    const int NT = 4 * (qblk + 1);
    u32x4 kr0, kr1, vr0, vr1;
#define KVROW(ti) ((ti) < 4 ? (unsigned)qblk * 256u + 64u * (unsigned)(ti) : (unsigned)((ti) - 4) * 64u)
#define LOADT(ti) do { const unsigned ro_ = kvoff + KVROW(ti) * 1024u; kr0 = *(const u32x4*)(Kb + ro_); kr1 = *(const u32x4*)(Kb + ro_ + 8); vr0 = *(const u32x4*)(Vb + ro_); vr1 = *(const u32x4*)(Vb + ro_ + 8); } while (0)
#define STORET(buf) do { LAS unsigned char* kb_ = lds + (buf) * 32768; *(LAS u32x4*)(kb_ + st_off0) = kr0; *(LAS u32x4*)(kb_ + st_off1) = kr1; *(LAS u32x4*)(kb_ + 16384 + st_off0) = vr0; *(LAS u32x4*)(kb_ + 16384 + st_off1) = vr1; } while (0)
    LOADT(0); STORET(0);
    __syncthreads();
    const unsigned pr = (unsigned)((q & 19) | ((q & 4) << 1) | ((q & 8) >> 1));
    const unsigned kx = ((pr & 3u) << 2) | ((pr >> 2) & 3u), krow = 256u * pr;
    float m_run = NEGB, l_run = 0.f;
    f32x16 o[4];
#pragma unroll
    for (int c = 0; c < 4; ++c)
#pragma unroll
        for (int r = 0; r < 16; ++r) o[c][r] = 0.f;
    for (int ti = 0; ti < NT; ++ti) {
        const bool more = (ti + 1 < NT);
        if (more) LOADT(ti + 1);
        __builtin_amdgcn_sched_barrier(0);
        const LAS unsigned char* Kt = lds + (ti & 1) * 32768; const LAS unsigned char* Vt = Kt + 16384;
        const bool own = ti < 4;
        bool lane_on = true, active = true;
        if (own) active = (w >= 2 * ti);
        else { lane_on = ((sel >> ((ti - 4) >> 2)) & 1u) != 0u; active = __any(lane_on) != 0; }
        if (active) {
            unsigned kx_ = kx, ln_ = (unsigned)lane;
            asm volatile("" : "+v"(kx_), "+v"(ln_));
            f32x16 p0, p1;
#pragma unroll
            for (int r = 0; r < 16; ++r) { p0[r] = 0.f; p1[r] = 0.f; }
#pragma unroll
            for (int s = 0; s < 8; ++s) {
                const unsigned ka = krow + 16u * ((unsigned)(2 * s + hi) ^ kx_);
                const bf16x8 a0 = *(const LAS bf16x8*)(Kt + ka), a1 = *(const LAS bf16x8*)(Kt + 8192 + ka);
                p0 = __builtin_amdgcn_mfma_f32_32x32x16_bf16(a0, qr[s], p0, 0, 0, 0);
                p1 = __builtin_amdgcn_mfma_f32_32x32x16_bf16(a1, qr[s], p1, 0, 0, 0);
                if (s & 1) __builtin_amdgcn_sched_barrier(0);
            }
            if (own) {
                if (w < 2 * ti + 2) { const int basek = 64 * ti + 8 * hi - (32 * w + q);
#pragma unroll
                    for (int r = 0; r < 16; ++r) { const int dk = basek + 16 * (r >> 3) + (r & 7); if (dk > 0) p0[r] = NEGB; if (dk + 32 > 0) p1[r] = NEGB; } }
            } else if (!lane_on) {
#pragma unroll
                for (int r = 0; r < 16; ++r) { p0[r] = NEGB; p1[r] = NEGB; }
            }
            float mx = fmaxf(p0[0], p1[0]);
#pragma unroll
            for (int r = 1; r < 16; ++r) mx = fmaxf(mx, fmaxf(p0[r], p1[r]));
            mx = fmaxf(mx, __shfl_xor(mx, 32));
            const float mn = fmaxf(m_run, mx), alpha = fast_exp2(m_run - mn);
            m_run = mn;
            float rs = 0.f;
#pragma unroll
            for (int r = 0; r < 16; ++r) { p0[r] = fast_exp2(p0[r] - mn); p1[r] = fast_exp2(p1[r] - mn); rs += p0[r] + p1[r]; }
            l_run = l_run * alpha + rs;
#pragma unroll
            for (int c = 0; c < 4; ++c)
#pragma unroll
                for (int r = 0; r < 16; ++r) o[c][r] *= alpha;
            bf16x8 pk[4];
            { u32x4 t0, t1, t2, t3;
              t0.x = cvt_pk_bf16(p0[0], p0[1]); t0.y = cvt_pk_bf16(p0[2], p0[3]); t0.z = cvt_pk_bf16(p0[4], p0[5]); t0.w = cvt_pk_bf16(p0[6], p0[7]);
              t1.x = cvt_pk_bf16(p0[8], p0[9]); t1.y = cvt_pk_bf16(p0[10], p0[11]); t1.z = cvt_pk_bf16(p0[12], p0[13]); t1.w = cvt_pk_bf16(p0[14], p0[15]);
              t2.x = cvt_pk_bf16(p1[0], p1[1]); t2.y = cvt_pk_bf16(p1[2], p1[3]); t2.z = cvt_pk_bf16(p1[4], p1[5]); t2.w = cvt_pk_bf16(p1[6], p1[7]);
              t3.x = cvt_pk_bf16(p1[8], p1[9]); t3.y = cvt_pk_bf16(p1[10], p1[11]); t3.z = cvt_pk_bf16(p1[12], p1[13]); t3.w = cvt_pk_bf16(p1[14], p1[15]);
              pk[0] = __builtin_bit_cast(bf16x8, t0); pk[1] = __builtin_bit_cast(bf16x8, t1); pk[2] = __builtin_bit_cast(bf16x8, t2); pk[3] = __builtin_bit_cast(bf16x8, t3); }
            __builtin_amdgcn_sched_barrier(0);
#pragma unroll
            for (int c = 0; c < 4; ++c) {
#pragma unroll
                for (int ks = 0; ks < 4; ++ks) {
                    const bf16x8 vf = tr_pair(Vt + (ks >> 1) * 8192, ln_, (unsigned)c, (unsigned)(ks & 1));
                    o[c] = __builtin_amdgcn_mfma_f32_32x32x16_bf16(vf, pk[ks], o[c], 0, 0, 0);
                }
                __builtin_amdgcn_sched_barrier(0);
            }
        }
        __builtin_amdgcn_sched_barrier(0);
        if (more) STORET((ti + 1) & 1);
        __syncthreads();
    }
#undef KVROW
#undef LOADT
#undef STORET
    const float lt = l_run + __shfl_xor(l_run, 32), inv = 1.0f / lt;
#pragma unroll
    for (int c = 0; c < 4; ++c)
#pragma unroll
        for (int g4 = 0; g4 < 4; ++g4) {
            u32x2 wv; wv.x = cvt_pk_bf16(o[c][4 * g4] * inv, o[c][4 * g4 + 1] * inv); wv.y = cvt_pk_bf16(o[c][4 * g4 + 2] * inv, o[c][4 * g4 + 3] * inv);
            *(u32x2*)(Qp + 32 * c + 8 * g4 + 4 * hi) = wv;
        }
#undef Qp
}

__device__ __forceinline__ void gmlp_unit(LAS unsigned char* lds, int b, int chunk, int gh, bf16_t* ycat, const bf16_t* V1, const bf16_t* Wsp, const float* ln_g, const float* ln_b, const float* b_sp) {
    const int tid = fresh_tid(), lane = tid & 63, w = __builtin_amdgcn_readfirstlane(tid >> 6), hi = lane >> 5;
    const size_t R0 = (size_t)b * SEQ + (size_t)chunk * 128;
    LAS unsigned char* VN = lds;
    LAS unsigned char* WS = lds + 32768;
    LAS float* stats = (LAS float*)(lds + 65536);
    for (int i = 0; i < 16; ++i) {
        const int row = 16 * w + i;
        const bf16_t* vr = V1 + (R0 + row) * 1024;
        const u32x4 a = *(const u32x4*)(vr + lane * 8), c = *(const u32x4*)(vr + 512 + lane * 8);
        float x[16];
        x[0] = bf_lo(a.x); x[1] = bf_hi(a.x); x[2] = bf_lo(a.y); x[3] = bf_hi(a.y); x[4] = bf_lo(a.z); x[5] = bf_hi(a.z); x[6] = bf_lo(a.w); x[7] = bf_hi(a.w);
        x[8] = bf_lo(c.x); x[9] = bf_hi(c.x); x[10] = bf_lo(c.y); x[11] = bf_hi(c.y); x[12] = bf_lo(c.z); x[13] = bf_hi(c.z); x[14] = bf_lo(c.w); x[15] = bf_hi(c.w);
        float s = 0.f;
#pragma unroll
        for (int k = 0; k < 16; ++k) s += x[k];
        const float mean = wave_sum(s) * (1.f / 1024.f);
        float s2 = 0.f;
#pragma unroll
        for (int k = 0; k < 16; ++k) { const float d = x[k] - mean; s2 += d * d; }
        const float rstd = 1.0f / sqrtf(wave_sum(s2) * (1.f / 1024.f) + EPS);
        if (lane == 0) { stats[2 * row] = mean; stats[2 * row + 1] = rstd; }
    }
    __syncthreads();
    const int wt = w & 3, wd = w >> 2, tl = lane & 31;
    const int ch = tid & 15;
    for (int gi = 0; gi < 4; ++gi) {
        const int g = 4 * gh + gi;
        const f32x4 lg0 = *(const f32x4*)(ln_g + g * 128 + ch * 8), lg1 = *(const f32x4*)(ln_g + g * 128 + ch * 8 + 4);
        const f32x4 lb0 = *(const f32x4*)(ln_b + g * 128 + ch * 8), lb1 = *(const f32x4*)(ln_b + g * 128 + ch * 8 + 4);
#pragma unroll
        for (int i = 0; i < 4; ++i) {
            const int row = (tid >> 4) + 32 * i;
            const u32x4 a = *(const u32x4*)(V1 + (R0 + row) * 1024 + g * 128 + ch * 8);
            const float mean = stats[2 * row], rstd = stats[2 * row + 1];
            f32x4 x0 = (f32x4){bf_lo(a.x), bf_hi(a.x), bf_lo(a.y), bf_hi(a.y)}, x1 = (f32x4){bf_lo(a.z), bf_hi(a.z), bf_lo(a.w), bf_hi(a.w)};
            x0 = (x0 - mean) * rstd * lg0 + lb0; x1 = (x1 - mean) * rstd * lg1 + lb1;
            u32x4 o; o.x = cvt_pk_bf16(x0[0], x0[1]); o.y = cvt_pk_bf16(x0[2], x0[3]); o.z = cvt_pk_bf16(x1[0], x1[1]); o.w = cvt_pk_bf16(x1[2], x1[3]);
            *(LAS u32x4*)(VN + (row >> 5) * 8192 + off_b(row & 31, ch)) = o;
            const u32x4 wv = *(const u32x4*)(Wsp + ((size_t)g * 128 + row) * 128 + ch * 8);
            *(LAS u32x4*)(WS + (row >> 5) * 8192 + off_b(row & 31, ch)) = wv;
        }
        __syncthreads();
        f32x16 acc[2];
#pragma unroll
        for (int c = 0; c < 2; ++c)
#pragma unroll
            for (int r = 0; r < 16; ++r) acc[c][r] = 0.f;
#pragma unroll
        for (int ks = 0; ks < 8; ++ks) {
            if (ks <= 2 * wt + 1) {
                const bf16x8 wf = *(const LAS bf16x8*)(WS + wt * 8192 + off_b(tl, 2 * ks + hi));
#pragma unroll
                for (int c = 0; c < 2; ++c) {
                    const bf16x8 vf = tr_pair(VN + (ks >> 1) * 8192, (unsigned)lane, (unsigned)(2 * wd + c), (unsigned)(ks & 1));
                    acc[c] = __builtin_amdgcn_mfma_f32_32x32x16_bf16(vf, wf, acc[c], 0, 0, 0);
                }
            }
        }
        const int t = 32 * wt + tl; const float bs = b_sp[g * 128 + t];
        bf16_t* up = ycat + (R0 + t) * 2048 + g * 128 + 64 * wd + 4 * hi;
#pragma unroll
        for (int c = 0; c < 2; ++c)
#pragma unroll
            for (int g4 = 0; g4 < 4; ++g4) {
                u32x2* p = (u32x2*)(up + 32 * c + 8 * g4); const u32x2 uu = *p;
                u32x2 wv; wv.x = cvt_pk_bf16(bf_lo(uu.x) * (acc[c][4 * g4] + bs), bf_hi(uu.x) * (acc[c][4 * g4 + 1] + bs));
                wv.y = cvt_pk_bf16(bf_lo(uu.y) * (acc[c][4 * g4 + 2] + bs), bf_hi(uu.y) * (acc[c][4 * g4 + 3] + bs));
                *p = wv;
            }
        __syncthreads();
    }
}

struct Args { const float* in[18]; float* out; unsigned char* ws; int ph_lo, ph_hi; };

__global__ void __launch_bounds__(512, 2) fwd_megakernel(Args args) {
    extern __shared__ __attribute__((aligned(16))) unsigned char lds_raw[];
    LAS unsigned char* lds = (LAS unsigned char*)lds_raw;
    const int G = gridDim.x, bx = blockIdx.x;
    const int vcu = (G % 8 == 0) ? (bx % 8) * (G / 8) + bx / 8 : bx;
    const int lo = args.ph_lo, hi = args.ph_hi;
    unsigned char* ws = args.ws;
    const float* x = args.in[0]; const float* cvec = args.in[1]; const float* w_ada = args.in[2]; const float* b_ada = args.in[3];
    const float* norm_mix_g = args.in[4]; const float* w_in = args.in[5]; const float* ln_v_g = args.in[6]; const float* ln_v_b = args.in[7];
    const float* w_spatial = args.in[8]; const float* b_spatial = args.in[9]; const float* w_proj_a = args.in[10]; const float* w_proj_b = args.in[11];
    const float* w_out = args.in[12]; const float* norm_ffn_g = args.in[13]; const float* w_ffn_gate = args.in[14]; const float* w_ffn_up = args.in[15];
    const float* w_ffn_down = args.in[16]; const float* norm_final_g = args.in[17];
    float* out = args.out;
    float* modp = (float*)(ws + WS_MODP); float* modf = (float*)(ws + WS_MODF); float* kpart = (float*)(ws + WS_KPART);
    bf16_t* Wsp = (bf16_t*)(ws + WS_WSP); bf16_t* Win_t = (bf16_t*)(ws + WS_WIN); bf16_t* Wab_t = (bf16_t*)(ws + WS_WAB); bf16_t* Wout_t = (bf16_t*)(ws + WS_WOUT);
    bf16_t* Wgu_t = (bf16_t*)(ws + WS_WGU); bf16_t* Wd_t = (bf16_t*)(ws + WS_WD);
    bf16_t* Hb = (bf16_t*)(ws + WS_H); bf16_t* Ycat = (bf16_t*)(ws + WS_YCAT); bf16_t* Kbuf = (bf16_t*)(ws + WS_K); bf16_t* Vbuf = (bf16_t*)(ws + WS_VV); bf16_t* V1 = (bf16_t*)(ws + WS_V1);
    bf16_t* Merged = Hb; bf16_t* H2 = V1; bf16_t* HF = Ycat;
    bf16_t* GA = (bf16_t*)out; bf16_t* GB = GA + (size_t)M_TOK * 1024;
    cg::grid_group grid = cg::this_grid();
#define IN(k) (lo <= (k) && (k) < hi)
#define SEAM(k) do { if (IN(k) && IN((k) + 1)) grid.sync(); } while (0)

    if (IN(0)) {
        const int tid = fresh_tid(), lane = tid & 63, wave = __builtin_amdgcn_readfirstlane(tid >> 6);
        LAS float* scr = (LAS float*)(lds + wave * 16384);
        const int gw = vcu * 8 + wave, NGW = G * 8;
        constexpr int I_IN = 16 * 224, I_P = 16 * 32, I_F = 16 * 88, I_D = 44 * 32;
        constexpr int NITEMS = I_IN + 3 * I_P + 2 * I_F + I_D;
        for (int it = gw; it < NITEMS; it += NGW) {
            int r = it;
            if (r < I_IN) { p0_transpose_item(w_in, IN_WIDTH, Win_t, 1024, 0, 32 * (r % 224), r / 224, r % 224, scr, lane); continue; } r -= I_IN;
            if (r < I_P) { p0_transpose_item(w_proj_a, 1024, Wab_t, 2048, 0, 32 * (r % 32), r / 32, r % 32, scr, lane); continue; } r -= I_P;
            if (r < I_P) { p0_transpose_item(w_proj_b, 1024, Wab_t, 2048, 1024, 32 * (r % 32), r / 32, r % 32, scr, lane); continue; } r -= I_P;
            if (r < I_P) { p0_transpose_item(w_out, 1024, Wout_t, 1024, 0, 32 * (r % 32), r / 32, r % 32, scr, lane); continue; } r -= I_P;
            if (r < I_F) { const int nb = r % 88, n0 = 32 * nb; p0_transpose_item(w_ffn_gate, FFN_H, Wgu_t, 1024, 0, (n0 >> 7) * 256 + (n0 & 127), r / 88, nb, scr, lane); continue; } r -= I_F;
            if (r < I_F) { const int nb = r % 88, n0 = 32 * nb; p0_transpose_item(w_ffn_up, FFN_H, Wgu_t, 1024, 0, (n0 >> 7) * 256 + 128 + (n0 & 127), r / 88, nb, scr, lane); continue; } r -= I_F;
            p0_transpose_item(w_ffn_down, 1024, Wd_t, FFN_H, 0, 32 * (r % 32), r / 32, r % 32, scr, lane);
        }
        { const int gt = (vcu * 512 + tid);
          if (gt < 16384) { const int e0 = gt * 8, t = (e0 >> 7) & 127, s0 = e0 & 127;
              const f32x4 a = *(const f32x4*)(w_spatial + e0), c = *(const f32x4*)(w_spatial + e0 + 4);
              float v[8] = {a[0], a[1], a[2], a[3], c[0], c[1], c[2], c[3]};
#pragma unroll
              for (int k = 0; k < 8; ++k) if (s0 + k > t) v[k] = 0.f;
              u32x4 o; o.x = cvt_pk_bf16(v[0], v[1]); o.y = cvt_pk_bf16(v[2], v[3]); o.z = cvt_pk_bf16(v[4], v[5]); o.w = cvt_pk_bf16(v[6], v[7]);
              *(u32x4*)(Wsp + e0) = o; } }
        for (int it = gw; it < 96 * 16; it += NGW) {
            const int jg = it % 96, kc = it / 96, j = jg * 64 + lane, k0 = kc * 64;
            float cv[4], ac[4];
#pragma unroll
            for (int bb = 0; bb < 4; ++bb) { const float c = cvec[bb * 1024 + k0 + lane]; cv[bb] = c / (1.f + __expf(-c)); ac[bb] = 0.f; }
#pragma unroll 16
            for (int kk = 0; kk < 64; ++kk) {
                const float wv = w_ada[(size_t)(k0 + kk) * N_MOD6 + j];
#pragma unroll
                for (int bb = 0; bb < 4; ++bb) ac[bb] += __uint_as_float(__builtin_amdgcn_readlane(__float_as_uint(cv[bb]), kk)) * wv;
            }
#pragma unroll
            for (int bb = 0; bb < 4; ++bb) modp[(size_t)(kc * 4 + bb) * N_MOD6 + j] = ac[bb];
        }
    }
    SEAM(0);

    if (IN(1)) {
        const int tid = fresh_tid(), lane = tid & 63, wave = __builtin_amdgcn_readfirstlane(tid >> 6);
        LAS float* Av = (LAS float*)lds; LAS float* Bv = Av + 1024;
        for (int chk = bx; chk < 256; chk += G) {
            const int b = chk >> 6;
            for (int c = tid; c < 1024; c += 512) {
                float sh = b_ada[c], sc = b_ada[1024 + c];
#pragma unroll
                for (int kc = 0; kc < 16; ++kc) { sh += modp[(size_t)(kc * 4 + b) * N_MOD6 + c]; sc += modp[(size_t)(kc * 4 + b) * N_MOD6 + 1024 + c]; }
                Av[c] = norm_mix_g[c] * (1.f + sc); Bv[c] = sh;
            }
            if (tid < 96) { const int idx = chk * 96 + tid, bb = idx / N_MOD6, j = idx % N_MOD6; float s = b_ada[j];
#pragma unroll
                for (int kc = 0; kc < 16; ++kc) s += modp[(size_t)(kc * 4 + bb) * N_MOD6 + j];
                modf[idx] = s; }
            __syncthreads();
            for (int i = 0; i < 8; ++i) { const size_t row = (size_t)chk * 64 + wave * 8 + i; rms_row<true>(x + row * 1024, Av, Bv, Hb + row * 1024, lane); }
            __syncthreads();
        }
    }
    SEAM(1);

    if (IN(2)) {
        pg8::Gemm g{Hb, Win_t, M_TOK, IN_WIDTH, 1024}; pg8::StaticOrder S; S.init(M_TOK, IN_WIDTH, G, bx);
        pg8::EpiIn E{Ycat, V1, Kbuf, Vbuf, GA, GB, kpart};
        pg8::gemm_phase<pg8::EpiIn, pg8::StaticOrder, true, true>(lds, g, S, E);
    }
    SEAM(2);

    if (IN(3)) {
        for (int v = vcu; v < 256; v += G) {
            const int bh = v >> 3, s = v & 7;
            attn_unit(lds, bh >> 3, bh & 7, 15 - s, Ycat, Kbuf, Vbuf, kpart);
            attn_unit(lds, bh >> 3, bh & 7, s, Ycat, Kbuf, Vbuf, kpart);
            gmlp_unit(lds, v >> 6, (v >> 1) & 31, v & 1, Ycat, V1, Wsp, ln_v_g, ln_v_b, b_spatial);
        }
    }
    SEAM(3);

    if (IN(4)) {
        pg8::Gemm g{Ycat, Wab_t, M_TOK, 1024, 2048}; pg8::StaticOrder S; S.init(M_TOK, 1024, G, bx);
        pg8::EpiMerged E{GA, GB, Merged};
        pg8::gemm_phase<pg8::EpiMerged, pg8::StaticOrder, true, true>(lds, g, S, E);
    }
    SEAM(4);

    if (IN(5)) {
        pg8::Gemm g{Merged, Wout_t, M_TOK, 1024, 1024}; pg8::StaticOrder S; S.init(M_TOK, 1024, G, bx);
        pg8::EpiResid E{x, out, modf + 2 * 1024};
        pg8::gemm_phase<pg8::EpiResid, pg8::StaticOrder, true, true>(lds, g, S, E);
    }
    SEAM(5);

    if (IN(6)) {
        const int tid = fresh_tid(), lane = tid & 63, wave = __builtin_amdgcn_readfirstlane(tid >> 6);
        LAS float* Av = (LAS float*)lds; LAS float* Bv = Av + 1024;
        for (int chk = bx; chk < 256; chk += G) {
            const int b = chk >> 6;
            for (int c = tid; c < 1024; c += 512) { Av[c] = norm_ffn_g[c] * (1.f + modf[b * N_MOD6 + 4 * 1024 + c]); Bv[c] = modf[b * N_MOD6 + 3 * 1024 + c]; }
            __syncthreads();
            for (int i = 0; i < 8; ++i) { const size_t row = (size_t)chk * 64 + wave * 8 + i; rms_row<true>(out + row * 1024, Av, Bv, H2 + row * 1024, lane); }
            __syncthreads();
        }
    }
    SEAM(6);

    if (IN(7)) {
        pg8::Gemm g{H2, Wgu_t, M_TOK, 2 * FFN_H, 1024}; pg8::StaticOrder S; S.init(M_TOK, 2 * FFN_H, G, bx);
        pg8::EpiSwiglu E{HF};
        pg8::gemm_phase<pg8::EpiSwiglu, pg8::StaticOrder, true, true>(lds, g, S, E);
    }
    SEAM(7);

    if (IN(8)) {
        pg8::Gemm g{HF, Wd_t, M_TOK, 1024, FFN_H}; pg8::StaticOrder S; S.init(M_TOK, 1024, G, bx);
        pg8::EpiResid E{out, out, modf + 5 * 1024};
        pg8::gemm_phase<pg8::EpiResid, pg8::StaticOrder, true, true>(lds, g, S, E);
    }
    SEAM(8);

    if (IN(9)) {
        const int tid = fresh_tid(), lane = tid & 63, wave = __builtin_amdgcn_readfirstlane(tid >> 6);
        LAS float* Av = (LAS float*)lds;
        for (int c = tid; c < 1024; c += 512) Av[c] = norm_final_g[c];
        __syncthreads();
        for (int chk = bx; chk < 256; chk += G)
            for (int i = 0; i < 8; ++i) { const size_t row = (size_t)chk * 64 + wave * 8 + i; rms_row<false>(out + row * 1024, Av, nullptr, out + row * 1024, lane); }
    }
#undef IN
#undef SEAM
}

extern "C" void kernel_launch(void* const* d_in, const int* in_sizes, int n_in, void* d_out, int out_size, void* d_ws, size_t ws_size, hipStream_t stream) {
    static int grid = 0;
    if (grid == 0) {
        if (n_in != 18 || out_size != M_TOK * D_MODEL || ws_size < WS_END) { fprintf(stderr, "kernel_launch: unexpected problem shape (n_in %d, out %d, ws %zu)\n", n_in, out_size, ws_size); grid = -1; return; }
        int dev = 0, cus = 0, per_cu = 0;
        (void)hipGetDevice(&dev);
        (void)hipDeviceGetAttribute(&cus, hipDeviceAttributeMultiprocessorCount, dev);
        if (hipFuncSetAttribute((const void*)fwd_megakernel, hipFuncAttributeMaxDynamicSharedMemorySize, LDS_BYTES) != hipSuccess) { fprintf(stderr, "kernel_launch: hipFuncSetAttribute failed\n"); grid = -1; return; }
        if (hipOccupancyMaxActiveBlocksPerMultiprocessor(&per_cu, (const void*)fwd_megakernel, 512, LDS_BYTES) != hipSuccess || per_cu < 1) per_cu = 1;
        (void)hipGetLastError();
        grid = cus * per_cu; if (grid > 256) grid = 256; if (grid < 1) grid = 256;
    }
    if (grid < 0) return;
    Args a{};
    for (int i = 0; i < 18; ++i) a.in[i] = (const float*)d_in[i];
    a.out = (float*)d_out; a.ws = (unsigned char*)d_ws;
#if MK_N_LAUNCHES == 1
    a.ph_lo = 0; a.ph_hi = NPHASE;
    void* kargs[] = {&a};
    hipError_t e = hipLaunchCooperativeKernel((const void*)fwd_megakernel, dim3(grid), dim3(512), kargs, LDS_BYTES, stream);
    if (e != hipSuccess) fprintf(stderr, "cooperative launch failed: %s (grid %d)\n", hipGetErrorString(e), grid);
#else
    for (int p = 0; p < NPHASE; ++p) {
        a.ph_lo = p; a.ph_hi = p + 1;
        hipLaunchKernelGGL(fwd_megakernel, dim3(grid), dim3(512), LDS_BYTES, stream, a);
    }
#endif
}
```

```cpp
#include <hip/hip_runtime.h>
#include <hip/hip_cooperative_groups.h>
#include <cstdio>
#include <cstdint>
namespace cg = cooperative_groups;

#define LAS __attribute__((address_space(3)))
typedef unsigned short bf16_t;
typedef short bf16x8 __attribute__((ext_vector_type(8)));
typedef short s16x4 __attribute__((ext_vector_type(4)));
typedef float f32x4 __attribute__((ext_vector_type(4)));
typedef float f32x2 __attribute__((ext_vector_type(2)));
typedef float f32x16 __attribute__((ext_vector_type(16)));
typedef unsigned u32x4 __attribute__((ext_vector_type(4)));
typedef unsigned u32x2 __attribute__((ext_vector_type(2)));

#ifndef MK_N_LAUNCHES
#define MK_N_LAUNCHES 1
#endif

constexpr int D_MODEL = 1024, BATCH = 4, SEQ = 4096, M_TOK = BATCH * SEQ;
constexpr int IN_WIDTH = 7168, FFN_H = 2816, N_MOD6 = 6 * D_MODEL;
constexpr float EPS = 1e-6f;
constexpr float QSCALE = 0.08838834764831845f * 1.4426950408889634f;
constexpr float NEGB = -1.0e30f;

__device__ __forceinline__ unsigned cvt_pk_bf16(float lo, float hi) { unsigned r; asm volatile("v_cvt_pk_bf16_f32 %0, %1, %2" : "=v"(r) : "v"(lo), "v"(hi)); return r; }
__device__ __forceinline__ float bf_lo(unsigned w) { return __uint_as_float(w << 16); }
__device__ __forceinline__ float bf_hi(unsigned w) { return __uint_as_float(w & 0xffff0000u); }
__device__ __forceinline__ float wave_sum(float v) {
#pragma unroll
    for (int o = 1; o < 64; o <<= 1) v += __shfl_xor(v, o);
    return v;
}
__device__ __forceinline__ int fresh_tid() { int t = threadIdx.x; asm volatile("" : "+v"(t)); return t; }
__device__ __forceinline__ float fast_rcp(float x) { return __builtin_amdgcn_rcpf(x); }
__device__ __forceinline__ float fast_exp2(float x) { return __builtin_amdgcn_exp2f(x); }

namespace pg8 {
constexpr int BM = 256, BK = 64, HALF = 128, HTB = HALF * BK * 2, STAGE_BYTES = 8 * HTB, NXCD = 8, WGM = 8;
__host__ __device__ __forceinline__ int lds_byte(int r, int c) { const int st = (r >> 4) * 2 + (c >> 5), rr = r & 15, cc = c & 31, ob = rr * 64 + cc * 2; return st * 1024 + (ob ^ (((ob >> 9) & 1) << 5)); }
__host__ __device__ __forceinline__ void stage_rc(int b, int& R, int& C) { const int st = b / 1024, sb = b % 1024, swz = sb ^ (((sb >> 9) & 1) << 5); R = (st >> 1) * 16 + swz / 64; C = (st & 1) * 32 + (swz % 64) / 2; }
__host__ __device__ __forceinline__ int perm32(int rho) { const int n = rho >> 4, i = rho & 15; return 8 * (i >> 2) + 4 * n + (i & 3); }

struct Unit { int pm, pn; };
struct Gemm { const bf16_t* A; const bf16_t* Bt; int M, N, K; };

struct StaticOrder {
    int nM, nN, nwg, G, c;
    __device__ void init(int M, int N, int G_, int c_) { nM = M / BM; nN = N / BM; nwg = nM * nN; G = G_; c = c_; }
    __device__ bool next(int i, Unit& u) const {
        const long L = (long)i * G + c; if (L >= nwg) return false;
        int wgid = (int)L; { const int q = nwg / NXCD, r = nwg % NXCD, xcd = wgid % NXCD, off = wgid / NXCD; wgid = (xcd < r ? xcd * (q + 1) : r * (q + 1) + (xcd - r) * q) + off; }
        const int nig = WGM * nN, gid = wgid / nig, fm = gid * WGM, gsz = (nM - fm) < WGM ? (nM - fm) : WGM;
        u.pm = fm + ((wgid % nig) % gsz); u.pn = (wgid % nig) / gsz; return true;
    }
};

typedef f32x4 Acc[2][2][4][2];

struct EpiIn {
    static constexpr bool PERM = true, HAS_MID = false;
    bf16_t* ycat; bf16_t* v1; bf16_t* kb; bf16_t* vv; bf16_t* ga; bf16_t* gb; float* kpart;
    __device__ __forceinline__ void mid(Acc&, const Unit&, int, int, int, int) const {}
    __device__ __forceinline__ void operator()(Acc& acc, const Unit& u, int wr, int wc, int fr, int fq) const {
        asm volatile("" : "+v"(fr), "+v"(fq));
        const int sec = u.pn >> 2, colt = (u.pn & 3) * BM;
        bf16_t* base; int ldc = 1024; bool sig = false, usex = false; float k1 = 0.f, k3 = 0.f, lin = 1.f;
        if (sec == 0) { base = ycat; ldc = 2048; sig = true; usex = true; k1 = 2.3022082f; k3 = 0.10294324f; }
        else if (sec == 1) { base = v1; sig = true; usex = true; k1 = 2.3022082f; k3 = 0.10294324f; }
        else if (sec == 2) { base = ycat + 1024; ldc = 2048; lin = QSCALE; }
        else if (sec == 3) { base = kb; }
        else if (sec == 4) { base = vv; }
        else if (sec == 5) { base = ga; sig = true; k1 = 1.4426950409f; }
        else { base = gb; sig = true; k1 = 1.4426950409f; }
        if (sec == 3) {
#pragma unroll
            for (int bj = 0; bj < 2; ++bj)
#pragma unroll
                for (int n = 0; n < 2; ++n) {
                    f32x4 s = (f32x4){0.f, 0.f, 0.f, 0.f};
#pragma unroll
                    for (int ai = 0; ai < 2; ++ai)
#pragma unroll
                        for (int m = 0; m < 4; ++m) s += acc[ai][bj][m][n];
#pragma unroll
                    for (int o = 1; o < 16; o <<= 1) { s[0] += __shfl_xor(s[0], o); s[1] += __shfl_xor(s[1], o); s[2] += __shfl_xor(s[2], o); s[3] += __shfl_xor(s[3], o); }
                    if (fr == 0) *(f32x4*)(kpart + (size_t)(u.pm * 2 + wr) * 1024 + colt + bj * HALF + wc * 32 + 8 * fq + 4 * n) = s;
                }
        }
        const int row0 = u.pm * BM + wr * 64 + fr, col0 = colt + wc * 32 + 8 * fq;
#pragma unroll
        for (int ai = 0; ai < 2; ++ai)
#pragma unroll
            for (int m = 0; m < 4; ++m) { bf16_t* rowp = base + (size_t)(row0 + ai * HALF + m * 16) * ldc + col0;
#pragma unroll
                for (int bj = 0; bj < 2; ++bj) { f32x4 v0 = acc[ai][bj][m][0], v1_ = acc[ai][bj][m][1];
                    if (sig) {
#pragma unroll
                        for (int i = 0; i < 4; ++i) {
                            { const float x = v0[i], z = x * (k1 + k3 * x * x), s = fast_rcp(1.f + fast_exp2(-z)); v0[i] = usex ? x * s : s; }
                            { const float x = v1_[i], z = x * (k1 + k3 * x * x), s = fast_rcp(1.f + fast_exp2(-z)); v1_[i] = usex ? x * s : s; }
                        }
                    } else { v0 = v0 * lin; v1_ = v1_ * lin; }
                    u32x4 w; w.x = cvt_pk_bf16(v0[0], v0[1]); w.y = cvt_pk_bf16(v0[2], v0[3]); w.z = cvt_pk_bf16(v1_[0], v1_[1]); w.w = cvt_pk_bf16(v1_[2], v1_[3]);
                    *(u32x4*)(rowp + bj * HALF) = w; } }
    }
};

struct EpiMerged {
    static constexpr bool PERM = true, HAS_MID = true;
    const bf16_t* ga; const bf16_t* gb; bf16_t* out;
    __device__ __forceinline__ void mid(Acc& acc, const Unit& u, int wr, int wc, int fr, int fq) const {
        asm volatile("" : "+v"(fr), "+v"(fq));
        const int row0 = u.pm * BM + wr * 64 + fr, col0 = u.pn * BM + wc * 32 + 8 * fq;
#pragma unroll
        for (int ai = 0; ai < 2; ++ai)
#pragma unroll
            for (int m = 0; m < 4; ++m) { const size_t off = (size_t)(row0 + ai * HALF + m * 16) * 1024 + col0;
#pragma unroll
                for (int bj = 0; bj < 2; ++bj) { const u32x4 a = *(const u32x4*)(ga + off + bj * HALF), b = *(const u32x4*)(gb + off + bj * HALF);
                    f32x4 r0, r1;
                    r0[0] = bf_lo(a.x) * fast_rcp(bf_lo(b.x)); r0[1] = bf_hi(a.x) * fast_rcp(bf_hi(b.x)); r0[2] = bf_lo(a.y) * fast_rcp(bf_lo(b.y)); r0[3] = bf_hi(a.y) * fast_rcp(bf_hi(b.y));
                    r1[0] = bf_lo(a.z) * fast_rcp(bf_lo(b.z)); r1[1] = bf_hi(a.z) * fast_rcp(bf_hi(b.z)); r1[2] = bf_lo(a.w) * fast_rcp(bf_lo(b.w)); r1[3] = bf_hi(a.w) * fast_rcp(bf_hi(b.w));
                    acc[ai][bj][m][0] *= r0; acc[ai][bj][m][1] *= r1; }
                asm volatile("" : "+v"(acc[ai][0][m][0]), "+v"(acc[ai][0][m][1]), "+v"(acc[ai][1][m][0]), "+v"(acc[ai][1][m][1]));
                asm volatile("" ::: "memory"); }
    }
    __device__ __forceinline__ void operator()(Acc& acc, const Unit& u, int wr, int wc, int fr, int fq) const {
        asm volatile("" : "+v"(fr), "+v"(fq));
        const int row0 = u.pm * BM + wr * 64 + fr, col0 = u.pn * BM + wc * 32 + 8 * fq;
#pragma unroll
        for (int ai = 0; ai < 2; ++ai)
#pragma unroll
            for (int m = 0; m < 4; ++m) { const size_t off = (size_t)(row0 + ai * HALF + m * 16) * 1024 + col0;
#pragma unroll
                for (int bj = 0; bj < 2; ++bj) { const u32x4 b = *(const u32x4*)(gb + off + bj * HALF);
                    const f32x4 v0 = acc[ai][bj][m][0], v1_ = acc[ai][bj][m][1];
                    u32x4 w; w.x = cvt_pk_bf16(v0[0] * bf_lo(b.x), v0[1] * bf_hi(b.x)); w.y = cvt_pk_bf16(v0[2] * bf_lo(b.y), v0[3] * bf_hi(b.y));
                    w.z = cvt_pk_bf16(v1_[0] * bf_lo(b.z), v1_[1] * bf_hi(b.z)); w.w = cvt_pk_bf16(v1_[2] * bf_lo(b.w), v1_[3] * bf_hi(b.w));
                    *(u32x4*)(out + off + bj * HALF) = w; } }
    }
};

struct EpiResid {
    static constexpr bool PERM = false, HAS_MID = false;
    const float* base; float* out; const float* gvec;
    __device__ __forceinline__ void mid(Acc&, const Unit&, int, int, int, int) const {}
    __device__ __forceinline__ void operator()(Acc& acc, const Unit& u, int wr, int wc, int fr, int fq) const {
        asm volatile("" : "+v"(fr), "+v"(fq));
        const int bidx = (u.pm * BM) / SEQ; const float* gv = gvec + (size_t)bidx * N_MOD6;
        const int row0 = u.pm * BM + wr * 64 + fr, col0 = u.pn * BM + wc * 32 + 4 * fq;
        f32x4 g4[2][2];
#pragma unroll
        for (int bj = 0; bj < 2; ++bj)
#pragma unroll
            for (int n = 0; n < 2; ++n) g4[bj][n] = *(const f32x4*)(gv + col0 + bj * HALF + n * 16);
#pragma unroll
        for (int ai = 0; ai < 2; ++ai)
#pragma unroll
            for (int m = 0; m < 4; ++m) { const size_t off = (size_t)(row0 + ai * HALF + m * 16) * 1024 + col0;
#pragma unroll
                for (int bj = 0; bj < 2; ++bj)
#pragma unroll
                    for (int n = 0; n < 2; ++n) { const f32x4 bs = *(const f32x4*)(base + off + bj * HALF + n * 16);
                        *(f32x4*)(out + off + bj * HALF + n * 16) = bs + g4[bj][n] * acc[ai][bj][m][n]; } }
    }
};

struct EpiSwiglu {
    static constexpr bool PERM = true, HAS_MID = false;
    bf16_t* out;
    __device__ __forceinline__ void mid(Acc&, const Unit&, int, int, int, int) const {}
    __device__ __forceinline__ void operator()(Acc& acc, const Unit& u, int wr, int wc, int fr, int fq) const {
        asm volatile("" : "+v"(fr), "+v"(fq));
        const int row0 = u.pm * BM + wr * 64 + fr, col0 = u.pn * HALF + wc * 32 + 8 * fq;
#pragma unroll
        for (int ai = 0; ai < 2; ++ai)
#pragma unroll
            for (int m = 0; m < 4; ++m) { bf16_t* rowp = out + (size_t)(row0 + ai * HALF + m * 16) * FFN_H + col0;
                float r[8];
#pragma unroll
                for (int n = 0; n < 2; ++n)
#pragma unroll
                    for (int i = 0; i < 4; ++i) { const float g = acc[ai][0][m][n][i], up = acc[ai][1][m][n][i];
                        r[4 * n + i] = g * fast_rcp(1.f + fast_exp2(-1.4426950409f * g)) * up; }
                u32x4 w; w.x = cvt_pk_bf16(r[0], r[1]); w.y = cvt_pk_bf16(r[2], r[3]); w.z = cvt_pk_bf16(r[4], r[5]); w.w = cvt_pk_bf16(r[6], r[7]);
                *(u32x4*)rowp = w; }
    }
};

template <class Epi, class Sched, bool ALIGN_EPI, bool SP2>
__device__ __forceinline__ void gemm_phase(LAS unsigned char* lds, const Gemm g, const Sched& S, const Epi& E) {
    const int tid = fresh_tid(), wid = __builtin_amdgcn_readfirstlane(tid >> 6), lane = tid & 63, wr = wid >> 2, wc = wid & 3, fr = lane & 15, fq = lane >> 4;
    const int K = g.K, nt = K / BK;
    unsigned voffA[2], voffB[2];
#pragma unroll
    for (int i = 0; i < 2; ++i) { int R, C; stage_rc(tid * 16 + i * 8192, R, C); const int Rb = Epi::PERM ? ((R & ~31) + perm32(R & 31)) : R;
        voffA[i] = (unsigned)(R * K + C) * 2u; voffB[i] = (unsigned)(Rb * K + C) * 2u; }
    const size_t kstep = (size_t)(BK * 2);
    const size_t hstep = (size_t)HALF * K * 2;
    const size_t tstep = 2 * hstep;
    const unsigned ldsw = (unsigned)wid * 1024u;
    const int aoff = lds_byte(wr * 64 + fr, fq * 8), boff = lds_byte(wc * 32 + fr, fq * 8);
#define PG8_SA(b, h) (((b) * 2 + (h)) * HTB)
#define PG8_SB(b, h) ((4 + (b) * 2 + (h)) * HTB)
#define PG8_STAGE(bufoff, gbase, voff) do { _Pragma("unroll") for (int _i = 0; _i < 2; ++_i) \
        __builtin_amdgcn_global_load_lds((const unsigned*)((const char*)(gbase) + (voff)[_i]), (LAS unsigned*)(lds + (bufoff) + ldsw + _i * 8192), 16, 0, 0); } while (0)
#define PG8_LDA(dst, b, h) do { _Pragma("unroll") for (int m = 0; m < 4; ++m) _Pragma("unroll") for (int k = 0; k < 2; ++k) dst[m][k] = *(const LAS bf16x8*)(lds + PG8_SA(b, h) + aoff + m * 2048 + k * 1024); } while (0)
#define PG8_LDB(dst, b, h) do { _Pragma("unroll") for (int n = 0; n < 2; ++n) _Pragma("unroll") for (int k = 0; k < 2; ++k) dst[n][k] = *(const LAS bf16x8*)(lds + PG8_SB(b, h) + boff + n * 2048 + k * 1024); } while (0)
#define PG8_MMA(ai, bj, At, Bt) do { __builtin_amdgcn_s_setprio(1); _Pragma("unroll") for (int m = 0; m < 4; ++m) _Pragma("unroll") for (int n = 0; n < 2; ++n) _Pragma("unroll") for (int k = 0; k < 2; ++k) \
        acc[ai][bj][m][n] = __builtin_amdgcn_mfma_f32_16x16x32_bf16(Bt[n][k], At[m][k], acc[ai][bj][m][n], 0, 0, 0); __builtin_amdgcn_s_setprio(0); } while (0)
#define PG8_WAIT_V(n) asm volatile("s_waitcnt vmcnt(" #n ")" ::: "memory")
#define PG8_WAIT_L(n) asm volatile("s_waitcnt lgkmcnt(" #n ")" ::: "memory")
#define PG8_BAR __builtin_amdgcn_s_barrier()
#define PG8_SCHED __builtin_amdgcn_sched_barrier(0)
    Unit cur, nxt; int ui = 0;
    if (!S.next(0, cur)) return;
    Acc acc;
#pragma unroll
    for (int a = 0; a < 2; ++a)
#pragma unroll
        for (int b = 0; b < 2; ++b)
#pragma unroll
            for (int m = 0; m < 4; ++m)
#pragma unroll
                for (int n = 0; n < 2; ++n) acc[a][b][m][n] = (f32x4){0.f, 0.f, 0.f, 0.f};
    bf16x8 At[4][2], B0[2][2], B1[2][2];
    const char* cA = (const char*)g.A + (size_t)cur.pm * tstep; const char* cB = (const char*)g.Bt + (size_t)cur.pn * tstep;
    if constexpr (SP2) {
        PG8_STAGE(PG8_SB(0, 0), cB, voffB); PG8_STAGE(PG8_SB(0, 1), cB + hstep, voffB); PG8_STAGE(PG8_SA(0, 0), cA, voffA); PG8_STAGE(PG8_SA(0, 1), cA + hstep, voffA);
        if (wr == 1) PG8_BAR;
        PG8_WAIT_V(2); PG8_BAR;
        PG8_STAGE(PG8_SB(1, 0), cB + kstep, voffB); PG8_STAGE(PG8_SA(1, 0), cA + kstep, voffA); PG8_STAGE(PG8_SB(1, 1), cB + hstep + kstep, voffB);
        PG8_WAIT_V(6); PG8_BAR;
    } else {
        PG8_STAGE(PG8_SB(0, 0), cB, voffB); PG8_STAGE(PG8_SA(0, 0), cA, voffA); PG8_STAGE(PG8_SB(0, 1), cB + hstep, voffB); PG8_STAGE(PG8_SA(0, 1), cA + hstep, voffA);
        if (wr == 1) PG8_BAR;
        PG8_WAIT_V(4); PG8_BAR;
        PG8_STAGE(PG8_SB(1, 0), cB + kstep, voffB); PG8_STAGE(PG8_SA(1, 0), cA + kstep, voffA); PG8_STAGE(PG8_SB(1, 1), cB + hstep + kstep, voffB);
        PG8_WAIT_V(6); PG8_BAR;
    }
    for (;;) {
        const bool has_next = S.next(ui + 1, nxt);
        const char* nA = has_next ? (const char*)g.A + (size_t)nxt.pm * tstep : cA; const char* nB = has_next ? (const char*)g.Bt + (size_t)nxt.pn * tstep : cB;
        for (int t = 0; t < nt; t += 2) {
            if constexpr (Epi::HAS_MID) { if (t == (nt >> 1)) E.mid(acc, cur, wr, wc, fr, fq); }
            const bool last = (t == nt - 2);
            const char* a1 = cA + (size_t)(t + 1) * kstep;
            const char* a2 = last ? nA : cA + (size_t)(t + 2) * kstep; const char* b2 = last ? nB : cB + (size_t)(t + 2) * kstep;
            const char* a3 = a2 + kstep; const char* b3 = b2 + kstep;
            if constexpr (SP2) {
            PG8_LDB(B0, 0, 0); PG8_LDB(B1, 0, 1); PG8_SCHED; PG8_LDA(At, 0, 0); PG8_STAGE(PG8_SA(1, 1), a1 + hstep, voffA);
            PG8_WAIT_V(8); PG8_WAIT_L(0); PG8_BAR; PG8_MMA(0, 0, At, B0); PG8_MMA(0, 1, At, B1); PG8_BAR; PG8_SCHED;
            PG8_LDA(At, 0, 1); PG8_STAGE(PG8_SB(0, 0), b2, voffB); PG8_STAGE(PG8_SB(0, 1), b2 + hstep, voffB); PG8_STAGE(PG8_SA(0, 0), a2, voffA);
            PG8_WAIT_V(8); PG8_WAIT_L(0); PG8_BAR; PG8_MMA(1, 0, At, B0); PG8_MMA(1, 1, At, B1); PG8_BAR; PG8_SCHED;
            PG8_LDB(B0, 1, 0); PG8_LDB(B1, 1, 1); PG8_SCHED; PG8_LDA(At, 1, 0); PG8_STAGE(PG8_SA(0, 1), a2 + hstep, voffA);
            PG8_WAIT_V(8); PG8_WAIT_L(0); PG8_BAR; PG8_MMA(0, 0, At, B0); PG8_MMA(0, 1, At, B1); PG8_BAR; PG8_SCHED;
            PG8_LDA(At, 1, 1); PG8_STAGE(PG8_SB(1, 0), b3, voffB); PG8_STAGE(PG8_SB(1, 1), b3 + hstep, voffB); PG8_STAGE(PG8_SA(1, 0), a3, voffA);
            PG8_WAIT_V(8); PG8_WAIT_L(0); PG8_BAR; PG8_MMA(1, 0, At, B0); PG8_MMA(1, 1, At, B1); PG8_BAR; PG8_SCHED;
            } else {
            PG8_LDB(B0, 0, 0); PG8_SCHED; PG8_LDA(At, 0, 0); PG8_STAGE(PG8_SA(1, 1), a1 + hstep, voffA);
            PG8_WAIT_L(8); PG8_BAR; PG8_WAIT_L(0); PG8_MMA(0, 0, At, B0); PG8_BAR; PG8_SCHED;
            PG8_LDB(B1, 0, 1); PG8_STAGE(PG8_SB(0, 0), b2, voffB);
            PG8_BAR; PG8_WAIT_L(0); PG8_MMA(0, 1, At, B1); PG8_BAR;
            PG8_LDA(At, 0, 1); PG8_STAGE(PG8_SA(0, 0), a2, voffA);
            PG8_BAR; PG8_WAIT_L(0); PG8_MMA(1, 0, At, B0); PG8_BAR; PG8_SCHED;
            PG8_STAGE(PG8_SB(0, 1), b2 + hstep, voffB);
            PG8_WAIT_V(6); PG8_BAR; PG8_MMA(1, 1, At, B1); PG8_BAR;
            PG8_LDB(B0, 1, 0); PG8_SCHED; PG8_LDA(At, 1, 0); PG8_STAGE(PG8_SA(0, 1), a2 + hstep, voffA);
            PG8_WAIT_L(8); PG8_BAR; PG8_WAIT_L(0); PG8_MMA(0, 0, At, B0); PG8_BAR; PG8_SCHED;
            PG8_LDB(B1, 1, 1); PG8_STAGE(PG8_SB(1, 0), b3, voffB);
            PG8_BAR; PG8_WAIT_L(0); PG8_MMA(0, 1, At, B1); PG8_BAR;
            PG8_LDA(At, 1, 1); PG8_STAGE(PG8_SA(1, 0), a3, voffA);
            PG8_BAR; PG8_WAIT_L(0); PG8_MMA(1, 0, At, B0); PG8_BAR; PG8_SCHED;
            PG8_STAGE(PG8_SB(1, 1), b3 + hstep, voffB);
            PG8_WAIT_V(6); PG8_BAR; PG8_MMA(1, 1, At, B1); PG8_BAR;
            }
        }
        if constexpr (ALIGN_EPI) { if (wr == 0) PG8_BAR; }
        E(acc, cur, wr, wc, fr, fq);
        if (!has_next) break;
#pragma unroll
        for (int a = 0; a < 2; ++a)
#pragma unroll
            for (int b = 0; b < 2; ++b)
#pragma unroll
                for (int m = 0; m < 4; ++m)
#pragma unroll
                    for (int n = 0; n < 2; ++n) acc[a][b][m][n] = (f32x4){0.f, 0.f, 0.f, 0.f};
        cur = nxt; cA = nA; cB = nB; ++ui;
        if constexpr (ALIGN_EPI) { if (wr == 1) PG8_BAR; }
    }
    PG8_WAIT_V(0);
    if constexpr (!ALIGN_EPI) { if (wr == 0) PG8_BAR; }
    PG8_BAR;
#undef PG8_SA
#undef PG8_SB
#undef PG8_STAGE
#undef PG8_LDA
#undef PG8_LDB
#undef PG8_MMA
#undef PG8_WAIT_V
#undef PG8_WAIT_L
#undef PG8_BAR
#undef PG8_SCHED
}
}

constexpr size_t MiB = 1u << 20;
constexpr size_t WS_MODP = 0;
constexpr size_t WS_MODF = 1536 * 1024;
constexpr size_t WS_KPART = WS_MODF + 128 * 1024;
constexpr size_t WS_WSP = WS_KPART + 512 * 1024;
constexpr size_t WS_CTL = 2560 * 1024;
constexpr size_t WS_WIN = 3 * MiB;
constexpr size_t WS_WAB = 17 * MiB;
constexpr size_t WS_WOUT = 21 * MiB;
constexpr size_t WS_WGU = 23 * MiB;
constexpr size_t WS_WD = 34 * MiB;
constexpr size_t WS_H = 40 * MiB;
constexpr size_t WS_YCAT = 72 * MiB;
constexpr size_t WS_K = 136 * MiB;
constexpr size_t WS_VV = 168 * MiB;
constexpr size_t WS_V1 = 200 * MiB;
constexpr size_t WS_END = 232 * MiB;
static_assert(WS_WSP + 256 * 1024 <= WS_WIN && WS_WD + (size_t)1024 * 2816 * 2 <= WS_H && WS_YCAT + (size_t)M_TOK * FFN_H * 2 <= WS_VV, "ws map");

constexpr int LDS_BYTES = 147456;
constexpr int NPHASE = 10;
constexpr int MISC_OFF = 139264;

__device__ __forceinline__ void p0_transpose_item(const float* W, int N, bf16_t* WT, int dpitch, int dkoff, int drow0, int kb, int nb, LAS float* scr, int lane) {
    const int k0 = 64 * kb, n0 = 32 * nb;
#pragma unroll 8
    for (int i = 0; i < 32; ++i) { const int kk = 2 * i + (lane >> 5); scr[kk * 33 + (lane & 31)] = W[(size_t)(k0 + kk) * N + n0 + (lane & 31)]; }
    asm volatile("s_waitcnt lgkmcnt(0)" ::: "memory");
    const int c = lane & 7;
#pragma unroll
    for (int j = 0; j < 4; ++j) { const int n = (lane >> 3) + 8 * j; const LAS float* s = scr + (8 * c) * 33 + n;
        u32x4 o; o.x = cvt_pk_bf16(s[0 * 33], s[1 * 33]); o.y = cvt_pk_bf16(s[2 * 33], s[3 * 33]); o.z = cvt_pk_bf16(s[4 * 33], s[5 * 33]); o.w = cvt_pk_bf16(s[6 * 33], s[7 * 33]);
        *(u32x4*)(WT + (size_t)(drow0 + n) * dpitch + dkoff + k0 + 8 * c) = o; }
    asm volatile("s_waitcnt lgkmcnt(0)" ::: "memory");
}

template <bool OUT_BF16>
__device__ __forceinline__ void rms_row(const float* xrow, const LAS float* Av, const LAS float* Bv, void* orow, int lane) {
    const f32x4* xr = (const f32x4*)xrow + lane;
    f32x4 v[4]; float s = 0.f;
#pragma unroll
    for (int j = 0; j < 4; ++j) { v[j] = xr[64 * j]; s += (v[j].x * v[j].x + v[j].y * v[j].y) + (v[j].z * v[j].z + v[j].w * v[j].w); }
    const float rstd = 1.0f / sqrtf(wave_sum(s) * (1.f / D_MODEL) + EPS);
#pragma unroll
    for (int j = 0; j < 4; ++j) {
        const f32x4 a = *(const LAS f32x4*)(Av + 4 * lane + 256 * j); f32x4 y = v[j] * rstd * a;
        if (Bv) y += *(const LAS f32x4*)(Bv + 4 * lane + 256 * j);
        if (OUT_BF16) { u32x2 w; w.x = cvt_pk_bf16(y.x, y.y); w.y = cvt_pk_bf16(y.z, y.w); *((u32x2*)orow + lane + 64 * j) = w; }
        else *((f32x4*)orow + lane + 64 * j) = y;
    }
}

__device__ __forceinline__ unsigned off_b(unsigned row, unsigned ch) { return 256u * row + 16u * (ch ^ (((row & 3u) << 2) | ((row >> 2) & 3u))); }
__device__ __forceinline__ unsigned tr_addr(unsigned lane, unsigned c, unsigned ks, unsigned t) {
    const unsigned h = lane >> 5, blk = (lane >> 4) & 1, q = (lane & 15) >> 2, p = lane & 3;
    return off_b(16 * ks + 8 * h + 4 * t + q, 4 * c + 2 * blk + (p >> 1)) + 8 * (p & 1);
}
__device__ __forceinline__ s16x4 tr_read(const LAS unsigned char* p) { return __builtin_bit_cast(s16x4, __builtin_amdgcn_ds_read_tr16_b64_v4i16((LAS s16x4*)p)); }
__device__ __forceinline__ bf16x8 tr_pair(const LAS unsigned char* base, unsigned lane, unsigned c, unsigned ks) {
    const s16x4 lo = tr_read(base + tr_addr(lane, c, ks, 0)), hi = tr_read(base + tr_addr(lane, c, ks, 1));
    return (bf16x8){lo[0], lo[1], lo[2], lo[3], hi[0], hi[1], hi[2], hi[3]};
}

__device__ __forceinline__ void attn_unit(LAS unsigned char* lds, int b, int h, int qblk, bf16_t* ycat, const bf16_t* Kb, const bf16_t* Vb, const float* kpart) {
    const int tid = fresh_tid(), lane = tid & 63, w = __builtin_amdgcn_readfirstlane(tid >> 6), q = lane & 31, hi = lane >> 5;
    const size_t rowbase = (size_t)b * SEQ;
    LAS float* kbar = (LAS float*)(lds + 65536);
    const unsigned qoff = (unsigned)((rowbase + (size_t)qblk * 256 + 32 * w + q) * 2048 + 1024 + h * 128);
#define Qp (ycat + qoff)
    bf16x8 qr[8];
#pragma unroll
    for (int s = 0; s < 8; ++s) qr[s] = *(const bf16x8*)(Qp + 16 * s + 8 * hi);
    for (int idx = tid; idx < qblk * 128; idx += 512) { const int j = idx >> 7, d = idx & 127; const float* kp = kpart + (size_t)((b * 16 + j) * 2) * 1024 + h * 128 + d; kbar[idx] = (kp[0] + kp[1024]) * (1.f / 256.f); }
    __syncthreads();
    float t1 = -3.0e38f, t2 = -3.0e38f, t3 = -3.0e38f; unsigned b1 = 0u, b2 = 0u, b3 = 0u;
#pragma unroll 1
    for (int j = 0; j < qblk; ++j) {
        float s0 = 0.f, s1 = 0.f;
#pragma unroll
        for (int s = 0; s < 8; ++s) {
            const f32x4 k0 = *(const LAS f32x4*)(kbar + j * 128 + 16 * s + 8 * hi), k1 = *(const LAS f32x4*)(kbar + j * 128 + 16 * s + 8 * hi + 4);
            const u32x4 qw = __builtin_bit_cast(u32x4, qr[s]);
            s0 += bf_lo(qw.x) * k0[0]; s1 += bf_hi(qw.x) * k0[1]; s0 += bf_lo(qw.y) * k0[2]; s1 += bf_hi(qw.y) * k0[3];
            s0 += bf_lo(qw.z) * k1[0]; s1 += bf_hi(qw.z) * k1[1]; s0 += bf_lo(qw.w) * k1[2]; s1 += bf_hi(qw.w) * k1[3];
        }
        const float part = s0 + s1;
        const float gj = part + __shfl_xor(part, 32);
        const unsigned bj = 1u << j;
        const bool c1 = gj > t1, c2 = gj > t2, c3 = gj > t3;
        t3 = c2 ? t2 : (c3 ? gj : t3); b3 = c2 ? b2 : (c3 ? bj : b3);
        t2 = c1 ? t1 : (c2 ? gj : t2); b2 = c1 ? b1 : (c2 ? bj : b2);
        t1 = c1 ? gj : t1;             b1 = c1 ? bj : b1;
    }
    const unsigned sel = b1 | b2 | b3;
    const int srow = tid >> 3, sch = (tid & 7) * 2;
    const unsigned st_off0 = (unsigned)(srow >> 5) * 8192u + off_b(srow & 31, sch), st_off1 = (unsigned)(srow >> 5) * 8192u + off_b(srow & 31, sch + 1);
    const unsigned kvoff = (unsigned)((rowbase + srow) * 1024 + h * 128 + sch * 8);
    const int NT = 4 * (qblk + 1);
    u32x4 kr0, kr1, vr0, vr1;
#define KVROW(ti) ((ti) < 4 ? (unsigned)qblk * 256u + 64u * (unsigned)(ti) : (unsigned)((ti) - 4) * 64u)
#define LOADT(ti) do { const unsigned ro_ = kvoff + KVROW(ti) * 1024u; kr0 = *(const u32x4*)(Kb + ro_); kr1 = *(const u32x4*)(Kb + ro_ + 8); vr0 = *(const u32x4*)(Vb + ro_); vr1 = *(const u32x4*)(Vb + ro_ + 8); } while (0)
#define STORET(buf) do { LAS unsigned char* kb_ = lds + (buf) * 32768; *(LAS u32x4*)(kb_ + st_off0) = kr0; *(LAS u32x4*)(kb_ + st_off1) = kr1; *(LAS u32x4*)(kb_ + 16384 + st_off0) = vr0; *(LAS u32x4*)(kb_ + 16384 + st_off1) = vr1; } while (0)
    LOADT(0); STORET(0);
    __syncthreads();
    const unsigned pr = (unsigned)((q & 19) | ((q & 4) << 1) | ((q & 8) >> 1));
    const unsigned kx = ((pr & 3u) << 2) | ((pr >> 2) & 3u), krow = 256u * pr;
    float m_run = NEGB, l_run = 0.f;
    f32x16 o[4];
#pragma unroll
    for (int c = 0; c < 4; ++c)
#pragma unroll
        for (int r = 0; r < 16; ++r) o[c][r] = 0.f;
    for (int ti = 0; ti < NT; ++ti) {
        const bool more = (ti + 1 < NT);
        if (more) LOADT(ti + 1);
        __builtin_amdgcn_sched_barrier(0);
        const LAS unsigned char* Kt = lds + (ti & 1) * 32768; const LAS unsigned char* Vt = Kt + 16384;
        const bool own = ti < 4;
        bool lane_on = true, active = true;
        if (own) active = (w >= 2 * ti);
        else { lane_on = ((sel >> ((ti - 4) >> 2)) & 1u) != 0u; active = __any(lane_on) != 0; }
        if (active) {
            unsigned kx_ = kx, ln_ = (unsigned)lane;
            asm volatile("" : "+v"(kx_), "+v"(ln_));
            f32x16 p0, p1;
#pragma unroll
            for (int r = 0; r < 16; ++r) { p0[r] = 0.f; p1[r] = 0.f; }
#pragma unroll
            for (int s = 0; s < 8; ++s) {
                const unsigned ka = krow + 16u * ((unsigned)(2 * s + hi) ^ kx_);
                const bf16x8 a0 = *(const LAS bf16x8*)(Kt + ka), a1 = *(const LAS bf16x8*)(Kt + 8192 + ka);
                p0 = __builtin_amdgcn_mfma_f32_32x32x16_bf16(a0, qr[s], p0, 0, 0, 0);
                p1 = __builtin_amdgcn_mfma_f32_32x32x16_bf16(a1, qr[s], p1, 0, 0, 0);
                if (s & 1) __builtin_amdgcn_sched_barrier(0);
            }
            if (own) {
                if (w < 2 * ti + 2) { const int basek = 64 * ti + 8 * hi - (32 * w + q);
#pragma unroll
                    for (int r = 0; r < 16; ++r) { const int dk = basek + 16 * (r >> 3) + (r & 7); if (dk > 0) p0[r] = NEGB; if (dk + 32 > 0) p1[r] = NEGB; } }
            } else if (!lane_on) {
#pragma unroll
                for (int r = 0; r < 16; ++r) { p0[r] = NEGB; p1[r] = NEGB; }
            }
            float mx = fmaxf(p0[0], p1[0]);
#pragma unroll
            for (int r = 1; r < 16; ++r) mx = fmaxf(mx, fmaxf(p0[r], p1[r]));
            mx = fmaxf(mx, __shfl_xor(mx, 32));
            const float mn = fmaxf(m_run, mx), alpha = fast_exp2(m_run - mn);
            m_run = mn;
            float rs = 0.f;
#pragma unroll
            for (int r = 0; r < 16; ++r) { p0[r] = fast_exp2(p0[r] - mn); p1[r] = fast_exp2(p1[r] - mn); rs += p0[r] + p1[r]; }
            l_run = l_run * alpha + rs;
#pragma unroll
            for (int c = 0; c < 4; ++c)
#pragma unroll
                for (int r = 0; r < 16; ++r) o[c][r] *= alpha;
            bf16x8 pk[4];
            { u32x4 t0, t1, t2, t3;
              t0.x = cvt_pk_bf16(p0[0], p0[1]); t0.y = cvt_pk_bf16(p0[2], p0[3]); t0.z = cvt_pk_bf16(p0[4], p0[5]); t0.w = cvt_pk_bf16(p0[6], p0[7]);
              t1.x = cvt_pk_bf16(p0[8], p0[9]); t1.y = cvt_pk_bf16(p0[10], p0[11]); t1.z = cvt_pk_bf16(p0[12], p0[13]); t1.w = cvt_pk_bf16(p0[14], p0[15]);
              t2.x = cvt_pk_bf16(p1[0], p1[1]); t2.y = cvt_pk_bf16(p1[2], p1[3]); t2.z = cvt_pk_bf16(p1[4], p1[5]); t2.w = cvt_pk_bf16(p1[6], p1[7]);
              t3.x = cvt_pk_bf16(p1[8], p1[9]); t3.y = cvt_pk_bf16(p1[10], p1[11]); t3.z = cvt_pk_bf16(p1[12], p1[13]); t3.w = cvt_pk_bf16(p1[14], p1[15]);
              pk[0] = __builtin_bit_cast(bf16x8, t0); pk[1] = __builtin_bit_cast(bf16x8, t1); pk[2] = __builtin_bit_cast(bf16x8, t2); pk[3] = __builtin_bit_cast(bf16x8, t3); }
            __builtin_amdgcn_sched_barrier(0);
#pragma unroll
            for (int c = 0; c < 4; ++c) {
#pragma unroll
                for (int ks = 0; ks < 4; ++ks) {
                    const bf16x8 vf = tr_pair(Vt + (ks >> 1) * 8192, ln_, (unsigned)c, (unsigned)(ks & 1));
                    o[c] = __builtin_amdgcn_mfma_f32_32x32x16_bf16(vf, pk[ks], o[c], 0, 0, 0);
                }
                __builtin_amdgcn_sched_barrier(0);
            }
        }
        __builtin_amdgcn_sched_barrier(0);
        if (more) STORET((ti + 1) & 1);
        __syncthreads();
    }
#undef KVROW
#undef LOADT
#undef STORET
    const float lt = l_run + __shfl_xor(l_run, 32), inv = 1.0f / lt;
#pragma unroll
    for (int c = 0; c < 4; ++c)
#pragma unroll
        for (int g4 = 0; g4 < 4; ++g4) {
            u32x2 wv; wv.x = cvt_pk_bf16(o[c][4 * g4] * inv, o[c][4 * g4 + 1] * inv); wv.y = cvt_pk_bf16(o[c][4 * g4 + 2] * inv, o[c][4 * g4 + 3] * inv);
            *(u32x2*)(Qp + 32 * c + 8 * g4 + 4 * hi) = wv;
        }
#undef Qp
}

__device__ __forceinline__ void gmlp_unit(LAS unsigned char* lds, int b, int chunk, int gh, bf16_t* ycat, const bf16_t* V1, const bf16_t* Wsp, const float* ln_g, const float* ln_b, const float* b_sp) {
    const int tid = fresh_tid(), lane = tid & 63, w = __builtin_amdgcn_readfirstlane(tid >> 6), hi = lane >> 5;
    const size_t R0 = (size_t)b * SEQ + (size_t)chunk * 128;
    LAS unsigned char* VN = lds;
    LAS unsigned char* WS = lds + 32768;
    LAS float* stats = (LAS float*)(lds + 65536);
    for (int i = 0; i < 16; ++i) {
        const int row = 16 * w + i;
        const bf16_t* vr = V1 + (R0 + row) * 1024;
        const u32x4 a = *(const u32x4*)(vr + lane * 8), c = *(const u32x4*)(vr + 512 + lane * 8);
        float x[16];
        x[0] = bf_lo(a.x); x[1] = bf_hi(a.x); x[2] = bf_lo(a.y); x[3] = bf_hi(a.y); x[4] = bf_lo(a.z); x[5] = bf_hi(a.z); x[6] = bf_lo(a.w); x[7] = bf_hi(a.w);
        x[8] = bf_lo(c.x); x[9] = bf_hi(c.x); x[10] = bf_lo(c.y); x[11] = bf_hi(c.y); x[12] = bf_lo(c.z); x[13] = bf_hi(c.z); x[14] = bf_lo(c.w); x[15] = bf_hi(c.w);
        float s = 0.f;
#pragma unroll
        for (int k = 0; k < 16; ++k) s += x[k];
        const float mean = wave_sum(s) * (1.f / 1024.f);
        float s2 = 0.f;
#pragma unroll
        for (int k = 0; k < 16; ++k) { const float d = x[k] - mean; s2 += d * d; }
        const float rstd = 1.0f / sqrtf(wave_sum(s2) * (1.f / 1024.f) + EPS);
        if (lane == 0) { stats[2 * row] = mean; stats[2 * row + 1] = rstd; }
    }
    __syncthreads();
    const int wt = w & 3, wd = w >> 2, tl = lane & 31;
    const int ch = tid & 15;
    for (int gi = 0; gi < 4; ++gi) {
        const int g = 4 * gh + gi;
        const f32x4 lg0 = *(const f32x4*)(ln_g + g * 128 + ch * 8), lg1 = *(const f32x4*)(ln_g + g * 128 + ch * 8 + 4);
        const f32x4 lb0 = *(const f32x4*)(ln_b + g * 128 + ch * 8), lb1 = *(const f32x4*)(ln_b + g * 128 + ch * 8 + 4);
#pragma unroll
        for (int i = 0; i < 4; ++i) {
            const int row = (tid >> 4) + 32 * i;
            const u32x4 a = *(const u32x4*)(V1 + (R0 + row) * 1024 + g * 128 + ch * 8);
            const float mean = stats[2 * row], rstd = stats[2 * row + 1];
            f32x4 x0 = (f32x4){bf_lo(a.x), bf_hi(a.x), bf_lo(a.y), bf_hi(a.y)}, x1 = (f32x4){bf_lo(a.z), bf_hi(a.z), bf_lo(a.w), bf_hi(a.w)};
            x0 = (x0 - mean) * rstd * lg0 + lb0; x1 = (x1 - mean) * rstd * lg1 + lb1;
            u32x4 o; o.x = cvt_pk_bf16(x0[0], x0[1]); o.y = cvt_pk_bf16(x0[2], x0[3]); o.z = cvt_pk_bf16(x1[0], x1[1]); o.w = cvt_pk_bf16(x1[2], x1[3]);
            *(LAS u32x4*)(VN + (row >> 5) * 8192 + off_b(row & 31, ch)) = o;
            const u32x4 wv = *(const u32x4*)(Wsp + ((size_t)g * 128 + row) * 128 + ch * 8);
            *(LAS u32x4*)(WS + (row >> 5) * 8192 + off_b(row & 31, ch)) = wv;
        }
        __syncthreads();
        f32x16 acc[2];
#pragma unroll
        for (int c = 0; c < 2; ++c)
#pragma unroll
            for (int r = 0; r < 16; ++r) acc[c][r] = 0.f;
#pragma unroll
        for (int ks = 0; ks < 8; ++ks) {
            if (ks <= 2 * wt + 1) {
                const bf16x8 wf = *(const LAS bf16x8*)(WS + wt * 8192 + off_b(tl, 2 * ks + hi));
#pragma unroll
                for (int c = 0; c < 2; ++c) {
                    const bf16x8 vf = tr_pair(VN + (ks >> 1) * 8192, (unsigned)lane, (unsigned)(2 * wd + c), (unsigned)(ks & 1));
                    acc[c] = __builtin_amdgcn_mfma_f32_32x32x16_bf16(vf, wf, acc[c], 0, 0, 0);
                }
            }
        }
        const int t = 32 * wt + tl; const float bs = b_sp[g * 128 + t];
        bf16_t* up = ycat + (R0 + t) * 2048 + g * 128 + 64 * wd + 4 * hi;
#pragma unroll
        for (int c = 0; c < 2; ++c)
#pragma unroll
            for (int g4 = 0; g4 < 4; ++g4) {
                u32x2* p = (u32x2*)(up + 32 * c + 8 * g4); const u32x2 uu = *p;
                u32x2 wv; wv.x = cvt_pk_bf16(bf_lo(uu.x) * (acc[c][4 * g4] + bs), bf_hi(uu.x) * (acc[c][4 * g4 + 1] + bs));
                wv.y = cvt_pk_bf16(bf_lo(uu.y) * (acc[c][4 * g4 + 2] + bs), bf_hi(uu.y) * (acc[c][4 * g4 + 3] + bs));
                *p = wv;
            }
        __syncthreads();
    }
}


#define XB_TMO      128
#define XB_XCNT(j)  (256  + 64 * (j))
#define XB_XSUB(j)  (1280 + 64 * (j))
#define XB_XGEN(j)  (2304 + 64 * (j))
#define XB_TOP      3328
#define XB_TOPGEN   3392
#define XCD_BAR_WORDS 3456
#define XB_SPIN_CAP (1u << 18)
__device__ __forceinline__ unsigned xb_ld(unsigned* p)              { return __hip_atomic_load(p, __ATOMIC_RELAXED, __HIP_MEMORY_SCOPE_AGENT); }
__device__ __forceinline__ unsigned xb_add(unsigned* p, unsigned v) { return __hip_atomic_fetch_add(p, v, __ATOMIC_RELAXED, __HIP_MEMORY_SCOPE_AGENT); }
__device__ __forceinline__ unsigned xb_xcc_id() { return (unsigned)__builtin_amdgcn_s_getreg((3 << 11) | 20) & 0xFu; }
#define XB_SPIN(cond, bar) do { unsigned _sp = 0; while (cond) { __builtin_amdgcn_s_sleep(1); \
    if ((++_sp & 255u) == 0u) { if (xb_ld(&(bar)[XB_TMO])) break; if (_sp > XB_SPIN_CAP) { atomicAdd(&(bar)[XB_TMO], 1u); break; } } } } while (0)
struct XcdBarrier { unsigned* bar; unsigned x; volatile LAS unsigned* st; };
__device__ __forceinline__ XcdBarrier xcd_barrier_post(unsigned* bar, volatile LAS unsigned* st) {
    XcdBarrier b; b.bar = bar; b.x = xb_xcc_id(); b.st = st;
    if (threadIdx.x == 0) (void)xb_add(&bar[XB_XCNT(b.x)], 1u);
    return b;
}
__device__ __forceinline__ void xcd_barrier_complete(unsigned* bar, unsigned x, unsigned& nloc, unsigned& nx) {
    const unsigned G = gridDim.x * gridDim.y * gridDim.z;
    unsigned sum, cnt, mine, sp = 0u;
    for (;;) {
        sum = 0u; cnt = 0u; mine = 0u;
#pragma unroll
        for (unsigned j = 0; j < 16; ++j) { const unsigned c = xb_ld(&bar[XB_XCNT(j)]); sum += c; cnt += (c > 0u) ? 1u : 0u; mine = (j == x) ? c : mine; }
        if (sum == G) break;
        __builtin_amdgcn_s_sleep(1);
        if ((++sp & 255u) == 0u) { if (xb_ld(&bar[XB_TMO])) break; if (sp > XB_SPIN_CAP) { atomicAdd(&bar[XB_TMO], 1u); break; } }
    }
    nloc = mine > 0u ? mine : 1u; nx = cnt > 0u ? cnt : 1u;
}
__device__ __forceinline__ void xcd_barrier(const XcdBarrier& b) {
    asm volatile("s_waitcnt vmcnt(0)" ::: "memory");
    __syncthreads();
    if (threadIdx.x == 0) {
        unsigned* bar = b.bar;
        __builtin_amdgcn_s_waitcnt(0);
        unsigned nloc = b.st[0], nx = b.st[1];
        if (nloc == 0u) { xcd_barrier_complete(bar, b.x, nloc, nx); b.st[0] = nloc; b.st[1] = nx; }
        const unsigned old = xb_add(&bar[XB_XSUB(b.x)], 1u);
        const unsigned gen = old / nloc;
        if (old + 1u == (gen + 1u) * nloc) {
            __builtin_amdgcn_fence(__ATOMIC_RELEASE, "agent");
            asm volatile("s_waitcnt vmcnt(0)" ::: "memory");
            const unsigned og = xb_add(&bar[XB_TOP], 1u);
            const unsigned tg = og / nx;
            if (og + 1u == (tg + 1u) * nx) xb_add(&bar[XB_TOPGEN], 1u);
            else XB_SPIN(xb_ld(&bar[XB_TOPGEN]) == tg, bar);
            __builtin_amdgcn_fence(__ATOMIC_ACQUIRE, "agent");
            xb_add(&bar[XB_XGEN(b.x)], 1u);
            asm volatile("s_waitcnt vmcnt(0)" ::: "memory");
        } else {
            XB_SPIN(xb_ld(&bar[XB_XGEN(b.x)]) == gen, bar);
            __builtin_amdgcn_fence(__ATOMIC_ACQUIRE, "agent");
            asm volatile("s_waitcnt vmcnt(0)" ::: "memory");
        }
    }
    __syncthreads();
}

struct Args { const float* in[18]; float* out; unsigned char* ws; int ph_lo, ph_hi; };

__global__ void __launch_bounds__(512, 2) fwd_megakernel(Args args) {
    extern __shared__ __attribute__((aligned(16))) unsigned char lds_raw[];
    LAS unsigned char* lds = (LAS unsigned char*)lds_raw;
    const int G = gridDim.x, bx = blockIdx.x;
    const int vcu = (G % 8 == 0) ? (bx % 8) * (G / 8) + bx / 8 : bx;
    const int lo = args.ph_lo, hi = args.ph_hi;
    unsigned char* ws = args.ws;
    const float* x = args.in[0]; const float* cvec = args.in[1]; const float* w_ada = args.in[2]; const float* b_ada = args.in[3];
    const float* norm_mix_g = args.in[4]; const float* w_in = args.in[5]; const float* ln_v_g = args.in[6]; const float* ln_v_b = args.in[7];
    const float* w_spatial = args.in[8]; const float* b_spatial = args.in[9]; const float* w_proj_a = args.in[10]; const float* w_proj_b = args.in[11];
    const float* w_out = args.in[12]; const float* norm_ffn_g = args.in[13]; const float* w_ffn_gate = args.in[14]; const float* w_ffn_up = args.in[15];
    const float* w_ffn_down = args.in[16]; const float* norm_final_g = args.in[17];
    float* out = args.out;
    float* modp = (float*)(ws + WS_MODP); float* modf = (float*)(ws + WS_MODF); float* kpart = (float*)(ws + WS_KPART);
    bf16_t* Wsp = (bf16_t*)(ws + WS_WSP); bf16_t* Win_t = (bf16_t*)(ws + WS_WIN); bf16_t* Wab_t = (bf16_t*)(ws + WS_WAB); bf16_t* Wout_t = (bf16_t*)(ws + WS_WOUT);
    bf16_t* Wgu_t = (bf16_t*)(ws + WS_WGU); bf16_t* Wd_t = (bf16_t*)(ws + WS_WD);
    bf16_t* Hb = (bf16_t*)(ws + WS_H); bf16_t* Ycat = (bf16_t*)(ws + WS_YCAT); bf16_t* Kbuf = (bf16_t*)(ws + WS_K); bf16_t* Vbuf = (bf16_t*)(ws + WS_VV); bf16_t* V1 = (bf16_t*)(ws + WS_V1);
    bf16_t* Merged = Hb; bf16_t* H2 = V1; bf16_t* HF = Ycat;
    bf16_t* GA = (bf16_t*)out; bf16_t* GB = GA + (size_t)M_TOK * 1024;
    cg::grid_group grid = cg::this_grid();
    volatile LAS unsigned* MISC = (volatile LAS unsigned*)(lds + MISC_OFF);
    if (threadIdx.x < 16) MISC[threadIdx.x] = 0u;
    __syncthreads();
    XcdBarrier bar; bar.bar = (unsigned*)(ws + WS_CTL); bar.x = 0; bar.st = MISC;
    if (hi - lo > 1) bar = xcd_barrier_post((unsigned*)(ws + WS_CTL), MISC);
    if (hi > 1000) grid.sync();
#define IN(k) (lo <= (k) && (k) < hi)
#define SEAM(k) do { if (IN(k) && IN((k) + 1)) xcd_barrier(bar); } while (0)

    if (IN(0)) {
        const int tid = fresh_tid(), lane = tid & 63, wave = __builtin_amdgcn_readfirstlane(tid >> 6);
        LAS float* scr = (LAS float*)(lds + wave * 16384);
        const int gw = vcu * 8 + wave, NGW = G * 8;
        constexpr int I_IN = 16 * 224, I_P = 16 * 32, I_F = 16 * 88, I_D = 44 * 32;
        constexpr int NITEMS = I_IN + 3 * I_P + 2 * I_F + I_D;
        for (int it = gw; it < NITEMS; it += NGW) {
            int r = it;
            if (r < I_IN) { p0_transpose_item(w_in, IN_WIDTH, Win_t, 1024, 0, 32 * (r % 224), r / 224, r % 224, scr, lane); continue; } r -= I_IN;
            if (r < I_P) { p0_transpose_item(w_proj_a, 1024, Wab_t, 2048, 0, 32 * (r % 32), r / 32, r % 32, scr, lane); continue; } r -= I_P;
            if (r < I_P) { p0_transpose_item(w_proj_b, 1024, Wab_t, 2048, 1024, 32 * (r % 32), r / 32, r % 32, scr, lane); continue; } r -= I_P;
            if (r < I_P) { p0_transpose_item(w_out, 1024, Wout_t, 1024, 0, 32 * (r % 32), r / 32, r % 32, scr, lane); continue; } r -= I_P;
            if (r < I_F) { const int nb = r % 88, n0 = 32 * nb; p0_transpose_item(w_ffn_gate, FFN_H, Wgu_t, 1024, 0, (n0 >> 7) * 256 + (n0 & 127), r / 88, nb, scr, lane); continue; } r -= I_F;
            if (r < I_F) { const int nb = r % 88, n0 = 32 * nb; p0_transpose_item(w_ffn_up, FFN_H, Wgu_t, 1024, 0, (n0 >> 7) * 256 + 128 + (n0 & 127), r / 88, nb, scr, lane); continue; } r -= I_F;
            p0_transpose_item(w_ffn_down, 1024, Wd_t, FFN_H, 0, 32 * (r % 32), r / 32, r % 32, scr, lane);
        }
        { const int gt = (vcu * 512 + tid);
          if (gt < 16384) { const int e0 = gt * 8, t = (e0 >> 7) & 127, s0 = e0 & 127;
              const f32x4 a = *(const f32x4*)(w_spatial + e0), c = *(const f32x4*)(w_spatial + e0 + 4);
              float v[8] = {a[0], a[1], a[2], a[3], c[0], c[1], c[2], c[3]};
#pragma unroll
              for (int k = 0; k < 8; ++k) if (s0 + k > t) v[k] = 0.f;
              u32x4 o; o.x = cvt_pk_bf16(v[0], v[1]); o.y = cvt_pk_bf16(v[2], v[3]); o.z = cvt_pk_bf16(v[4], v[5]); o.w = cvt_pk_bf16(v[6], v[7]);
              *(u32x4*)(Wsp + e0) = o; } }
        for (int it = gw; it < 96 * 16; it += NGW) {
            const int jg = it % 96, kc = it / 96, j = jg * 64 + lane, k0 = kc * 64;
            float cv[4], ac[4];
#pragma unroll
            for (int bb = 0; bb < 4; ++bb) { const float c = cvec[bb * 1024 + k0 + lane]; cv[bb] = c / (1.f + __expf(-c)); ac[bb] = 0.f; }
#pragma unroll 16
            for (int kk = 0; kk < 64; ++kk) {
                const float wv = w_ada[(size_t)(k0 + kk) * N_MOD6 + j];
#pragma unroll
                for (int bb = 0; bb < 4; ++bb) ac[bb] += __uint_as_float(__builtin_amdgcn_readlane(__float_as_uint(cv[bb]), kk)) * wv;
            }
#pragma unroll
            for (int bb = 0; bb < 4; ++bb) modp[(size_t)(kc * 4 + bb) * N_MOD6 + j] = ac[bb];
        }
    }
    SEAM(0);

    if (IN(1)) {
        const int tid = fresh_tid(), lane = tid & 63, wave = __builtin_amdgcn_readfirstlane(tid >> 6);
        LAS float* Av = (LAS float*)lds; LAS float* Bv = Av + 1024;
        for (int chk = bx; chk < 256; chk += G) {
            const int b = chk >> 6;
            for (int c = tid; c < 1024; c += 512) {
                float sh = b_ada[c], sc = b_ada[1024 + c];
#pragma unroll
                for (int kc = 0; kc < 16; ++kc) { sh += modp[(size_t)(kc * 4 + b) * N_MOD6 + c]; sc += modp[(size_t)(kc * 4 + b) * N_MOD6 + 1024 + c]; }
                Av[c] = norm_mix_g[c] * (1.f + sc); Bv[c] = sh;
            }
            if (tid < 96) { const int idx = chk * 96 + tid, bb = idx / N_MOD6, j = idx % N_MOD6; float s = b_ada[j];
#pragma unroll
                for (int kc = 0; kc < 16; ++kc) s += modp[(size_t)(kc * 4 + bb) * N_MOD6 + j];
                modf[idx] = s; }
            __syncthreads();
            for (int i = 0; i < 8; ++i) { const size_t row = (size_t)chk * 64 + wave * 8 + i; rms_row<true>(x + row * 1024, Av, Bv, Hb + row * 1024, lane); }
            __syncthreads();
        }
    }
    SEAM(1);

    if (IN(2)) {
        pg8::Gemm g{Hb, Win_t, M_TOK, IN_WIDTH, 1024}; pg8::StaticOrder S; S.init(M_TOK, IN_WIDTH, G, bx);
        pg8::EpiIn E{Ycat, V1, Kbuf, Vbuf, GA, GB, kpart};
        pg8::gemm_phase<pg8::EpiIn, pg8::StaticOrder, true, true>(lds, g, S, E);
    }
    SEAM(2);

    if (IN(3)) {
        for (int v = vcu; v < 256; v += G) {
            const int bh = v >> 3, s = v & 7;
            attn_unit(lds, bh >> 3, bh & 7, 15 - s, Ycat, Kbuf, Vbuf, kpart);
            attn_unit(lds, bh >> 3, bh & 7, s, Ycat, Kbuf, Vbuf, kpart);
            gmlp_unit(lds, v >> 6, (v >> 1) & 31, v & 1, Ycat, V1, Wsp, ln_v_g, ln_v_b, b_spatial);
        }
    }
    SEAM(3);

    if (IN(4)) {
        pg8::Gemm g{Ycat, Wab_t, M_TOK, 1024, 2048}; pg8::StaticOrder S; S.init(M_TOK, 1024, G, bx);
        pg8::EpiMerged E{GA, GB, Merged};
        pg8::gemm_phase<pg8::EpiMerged, pg8::StaticOrder, true, true>(lds, g, S, E);
    }
    SEAM(4);

    if (IN(5)) {
        pg8::Gemm g{Merged, Wout_t, M_TOK, 1024, 1024}; pg8::StaticOrder S; S.init(M_TOK, 1024, G, bx);
        pg8::EpiResid E{x, out, modf + 2 * 1024};
        pg8::gemm_phase<pg8::EpiResid, pg8::StaticOrder, true, true>(lds, g, S, E);
    }
    SEAM(5);

    if (IN(6)) {
        const int tid = fresh_tid(), lane = tid & 63, wave = __builtin_amdgcn_readfirstlane(tid >> 6);
        LAS float* Av = (LAS float*)lds; LAS float* Bv = Av + 1024;
        for (int chk = bx; chk < 256; chk += G) {
            const int b = chk >> 6;
            for (int c = tid; c < 1024; c += 512) { Av[c] = norm_ffn_g[c] * (1.f + modf[b * N_MOD6 + 4 * 1024 + c]); Bv[c] = modf[b * N_MOD6 + 3 * 1024 + c]; }
            __syncthreads();
            for (int i = 0; i < 8; ++i) { const size_t row = (size_t)chk * 64 + wave * 8 + i; rms_row<true>(out + row * 1024, Av, Bv, H2 + row * 1024, lane); }
            __syncthreads();
        }
    }
    SEAM(6);

    if (IN(7)) {
        pg8::Gemm g{H2, Wgu_t, M_TOK, 2 * FFN_H, 1024}; pg8::StaticOrder S; S.init(M_TOK, 2 * FFN_H, G, bx);
        pg8::EpiSwiglu E{HF};
        pg8::gemm_phase<pg8::EpiSwiglu, pg8::StaticOrder, true, true>(lds, g, S, E);
    }
    SEAM(7);

    if (IN(8)) {
        pg8::Gemm g{HF, Wd_t, M_TOK, 1024, FFN_H}; pg8::StaticOrder S; S.init(M_TOK, 1024, G, bx);
        pg8::EpiResid E{out, out, modf + 5 * 1024};
        pg8::gemm_phase<pg8::EpiResid, pg8::StaticOrder, true, true>(lds, g, S, E);
    }
    SEAM(8);

    if (IN(9)) {
        const int tid = fresh_tid(), lane = tid & 63, wave = __builtin_amdgcn_readfirstlane(tid >> 6);
        LAS float* Av = (LAS float*)lds;
        for (int c = tid; c < 1024; c += 512) Av[c] = norm_final_g[c];
        __syncthreads();
        for (int chk = bx; chk < 256; chk += G)
            for (int i = 0; i < 8; ++i) { const size_t row = (size_t)chk * 64 + wave * 8 + i; rms_row<false>(out + row * 1024, Av, nullptr, out + row * 1024, lane); }
    }
#undef IN
#undef SEAM
}

extern "C" void kernel_launch(void* const* d_in, const int* in_sizes, int n_in, void* d_out, int out_size, void* d_ws, size_t ws_size, hipStream_t stream) {
    static int grid = 0;
    if (grid == 0) {
        if (n_in != 18 || out_size != M_TOK * D_MODEL || ws_size < WS_END) { fprintf(stderr, "kernel_launch: unexpected problem shape (n_in %d, out %d, ws %zu)\n", n_in, out_size, ws_size); grid = -1; return; }
        int dev = 0, cus = 0, per_cu = 0;
        (void)hipGetDevice(&dev);
        (void)hipDeviceGetAttribute(&cus, hipDeviceAttributeMultiprocessorCount, dev);
        if (hipFuncSetAttribute((const void*)fwd_megakernel, hipFuncAttributeMaxDynamicSharedMemorySize, LDS_BYTES) != hipSuccess) { fprintf(stderr, "kernel_launch: hipFuncSetAttribute failed\n"); grid = -1; return; }
        if (hipOccupancyMaxActiveBlocksPerMultiprocessor(&per_cu, (const void*)fwd_megakernel, 512, LDS_BYTES) != hipSuccess || per_cu < 1) per_cu = 1;
        (void)hipGetLastError();
        grid = cus * per_cu; if (grid > 256) grid = 256; if (grid < 1) grid = 256;
    }
    if (grid < 0) return;
    (void)hipMemsetAsync((unsigned char*)d_ws + WS_CTL, 0, 16384, stream);
    Args a{};
    for (int i = 0; i < 18; ++i) a.in[i] = (const float*)d_in[i];
    a.out = (float*)d_out; a.ws = (unsigned char*)d_ws;
#if MK_N_LAUNCHES == 1
    a.ph_lo = 0; a.ph_hi = NPHASE;
    void* kargs[] = {&a};
    hipError_t e = hipLaunchCooperativeKernel((const void*)fwd_megakernel, dim3(grid), dim3(512), kargs, LDS_BYTES, stream);
    if (e != hipSuccess) fprintf(stderr, "cooperative launch failed: %s (grid %d)\n", hipGetErrorString(e), grid);
#else
    for (int p = 0; p < NPHASE; ++p) {
        a.ph_lo = p; a.ph_hi = p + 1;
        hipLaunchKernelGGL(fwd_megakernel, dim3(grid), dim3(512), LDS_BYTES, stream, a);
    }
#endif
}
```

```cpp
#include <hip/hip_runtime.h>
#include <hip/hip_cooperative_groups.h>
#include <cstdio>
#include <cstdint>
namespace cg = cooperative_groups;

#define LAS __attribute__((address_space(3)))
typedef unsigned short bf16_t;
typedef short bf16x8 __attribute__((ext_vector_type(8)));
typedef short s16x4 __attribute__((ext_vector_type(4)));
typedef float f32x4 __attribute__((ext_vector_type(4)));
typedef float f32x2 __attribute__((ext_vector_type(2)));
typedef float f32x16 __attribute__((ext_vector_type(16)));
typedef unsigned u32x4 __attribute__((ext_vector_type(4)));
typedef unsigned u32x2 __attribute__((ext_vector_type(2)));

#ifndef MK_N_LAUNCHES
#define MK_N_LAUNCHES 1
#endif

constexpr int D_MODEL = 1024, BATCH = 4, SEQ = 4096, M_TOK = BATCH * SEQ;
constexpr int IN_WIDTH = 7168, FFN_H = 2816, N_MOD6 = 6 * D_MODEL;
constexpr float EPS = 1e-6f;
constexpr float QSCALE = 0.08838834764831845f * 1.4426950408889634f;
constexpr float NEGB = -1.0e30f;

__device__ __forceinline__ unsigned cvt_pk_bf16(float lo, float hi) { unsigned r; asm volatile("v_cvt_pk_bf16_f32 %0, %1, %2" : "=v"(r) : "v"(lo), "v"(hi)); return r; }
__device__ __forceinline__ float bf_lo(unsigned w) { return __uint_as_float(w << 16); }
__device__ __forceinline__ float bf_hi(unsigned w) { return __uint_as_float(w & 0xffff0000u); }
__device__ __forceinline__ float wave_sum(float v) {
#pragma unroll
    for (int o = 1; o < 64; o <<= 1) v += __shfl_xor(v, o);
    return v;
}
__device__ __forceinline__ int fresh_tid() { int t = threadIdx.x; asm volatile("" : "+v"(t)); return t; }
__device__ __forceinline__ float fast_rcp(float x) { return __builtin_amdgcn_rcpf(x); }
__device__ __forceinline__ float fast_exp2(float x) { return __builtin_amdgcn_exp2f(x); }

namespace pg8 {
constexpr int BM = 256, BK = 64, HALF = 128, HTB = HALF * BK * 2, STAGE_BYTES = 8 * HTB, NXCD = 8, WGM = 8;
__host__ __device__ __forceinline__ int lds_byte(int r, int c) { const int st = (r >> 4) * 2 + (c >> 5), rr = r & 15, cc = c & 31, ob = rr * 64 + cc * 2; return st * 1024 + (ob ^ (((ob >> 9) & 1) << 5)); }
__host__ __device__ __forceinline__ void stage_rc(int b, int& R, int& C) { const int st = b / 1024, sb = b % 1024, swz = sb ^ (((sb >> 9) & 1) << 5); R = (st >> 1) * 16 + swz / 64; C = (st & 1) * 32 + (swz % 64) / 2; }
__host__ __device__ __forceinline__ int perm32(int rho) { const int n = rho >> 4, i = rho & 15; return 8 * (i >> 2) + 4 * n + (i & 3); }

struct Unit { int pm, pn; };
struct Gemm { const bf16_t* A; const bf16_t* Bt; int M, N, K; };

struct StaticOrder {
    int nM, nN, nwg, G, c;
    __device__ void init(int M, int N, int G_, int c_) { nM = M / BM; nN = N / BM; nwg = nM * nN; G = G_; c = c_; }
    __device__ bool next(int i, Unit& u) const {
        const long L = (long)i * G + c; if (L >= nwg) return false;
        int wgid = (int)L; { const int q = nwg / NXCD, r = nwg % NXCD, xcd = wgid % NXCD, off = wgid / NXCD; wgid = (xcd < r ? xcd * (q + 1) : r * (q + 1) + (xcd - r) * q) + off; }
        const int nig = WGM * nN, gid = wgid / nig, fm = gid * WGM, gsz = (nM - fm) < WGM ? (nM - fm) : WGM;
        u.pm = fm + ((wgid % nig) % gsz); u.pn = (wgid % nig) / gsz; return true;
    }
};

typedef f32x4 Acc[2][2][4][2];

struct EpiIn {
    static constexpr bool PERM = true, HAS_MID = false;
    bf16_t* ycat; bf16_t* v1; bf16_t* kb; bf16_t* vv; bf16_t* ga; bf16_t* gb; float* kpart;
    __device__ __forceinline__ void mid(Acc&, const Unit&, int, int, int, int) const {}
    __device__ __forceinline__ void operator()(Acc& acc, const Unit& u, int wr, int wc, int fr, int fq) const {
        asm volatile("" : "+v"(fr), "+v"(fq));
        const int sec = u.pn >> 2, colt = (u.pn & 3) * BM;
        bf16_t* base; int ldc = 1024; bool sig = false, usex = false; float k1 = 0.f, k3 = 0.f, lin = 1.f;
        if (sec == 0) { base = ycat; ldc = 2048; sig = true; usex = true; k1 = 2.3022082f; k3 = 0.10294324f; }
        else if (sec == 1) { base = v1; sig = true; usex = true; k1 = 2.3022082f; k3 = 0.10294324f; }
        else if (sec == 2) { base = ycat + 1024; ldc = 2048; lin = QSCALE; }
        else if (sec == 3) { base = kb; }
        else if (sec == 4) { base = vv; }
        else if (sec == 5) { base = ga; sig = true; k1 = 1.4426950409f; }
        else { base = gb; sig = true; k1 = 1.4426950409f; }
        if (sec == 3) {
#pragma unroll
            for (int bj = 0; bj < 2; ++bj)
#pragma unroll
                for (int n = 0; n < 2; ++n) {
                    f32x4 s = (f32x4){0.f, 0.f, 0.f, 0.f};
#pragma unroll
                    for (int ai = 0; ai < 2; ++ai)
#pragma unroll
                        for (int m = 0; m < 4; ++m) s += acc[ai][bj][m][n];
#pragma unroll
                    for (int o = 1; o < 16; o <<= 1) { s[0] += __shfl_xor(s[0], o); s[1] += __shfl_xor(s[1], o); s[2] += __shfl_xor(s[2], o); s[3] += __shfl_xor(s[3], o); }
                    if (fr == 0) *(f32x4*)(kpart + (size_t)(u.pm * 2 + wr) * 1024 + colt + bj * HALF + wc * 32 + 8 * fq + 4 * n) = s;
                }
        }
        const int row0 = u.pm * BM + wr * 64 + fr, col0 = colt + wc * 32 + 8 * fq;
#pragma unroll
        for (int ai = 0; ai < 2; ++ai)
#pragma unroll
            for (int m = 0; m < 4; ++m) { bf16_t* rowp = base + (size_t)(row0 + ai * HALF + m * 16) * ldc + col0;
#pragma unroll
                for (int bj = 0; bj < 2; ++bj) { f32x4 v0 = acc[ai][bj][m][0], v1_ = acc[ai][bj][m][1];
                    if (sig) {
#pragma unroll
                        for (int i = 0; i < 4; ++i) {
                            { const float x = v0[i], z = x * (k1 + k3 * x * x), s = fast_rcp(1.f + fast_exp2(-z)); v0[i] = usex ? x * s : s; }
                            { const float x = v1_[i], z = x * (k1 + k3 * x * x), s = fast_rcp(1.f + fast_exp2(-z)); v1_[i] = usex ? x * s : s; }
                        }
                    } else { v0 = v0 * lin; v1_ = v1_ * lin; }
                    u32x4 w; w.x = cvt_pk_bf16(v0[0], v0[1]); w.y = cvt_pk_bf16(v0[2], v0[3]); w.z = cvt_pk_bf16(v1_[0], v1_[1]); w.w = cvt_pk_bf16(v1_[2], v1_[3]);
                    *(u32x4*)(rowp + bj * HALF) = w; } }
    }
};

struct EpiMerged {
    static constexpr bool PERM = true, HAS_MID = true;
    const bf16_t* ga; const bf16_t* gb; bf16_t* out;
    __device__ __forceinline__ void mid(Acc& acc, const Unit& u, int wr, int wc, int fr, int fq) const {
        asm volatile("" : "+v"(fr), "+v"(fq));
        const int row0 = u.pm * BM + wr * 64 + fr, col0 = u.pn * BM + wc * 32 + 8 * fq;
#pragma unroll
        for (int ai = 0; ai < 2; ++ai)
#pragma unroll
            for (int m = 0; m < 4; ++m) { const size_t off = (size_t)(row0 + ai * HALF + m * 16) * 1024 + col0;
#pragma unroll
                for (int bj = 0; bj < 2; ++bj) { const u32x4 a = *(const u32x4*)(ga + off + bj * HALF), b = *(const u32x4*)(gb + off + bj * HALF);
                    f32x4 r0, r1;
                    r0[0] = bf_lo(a.x) * fast_rcp(bf_lo(b.x)); r0[1] = bf_hi(a.x) * fast_rcp(bf_hi(b.x)); r0[2] = bf_lo(a.y) * fast_rcp(bf_lo(b.y)); r0[3] = bf_hi(a.y) * fast_rcp(bf_hi(b.y));
                    r1[0] = bf_lo(a.z) * fast_rcp(bf_lo(b.z)); r1[1] = bf_hi(a.z) * fast_rcp(bf_hi(b.z)); r1[2] = bf_lo(a.w) * fast_rcp(bf_lo(b.w)); r1[3] = bf_hi(a.w) * fast_rcp(bf_hi(b.w));
                    acc[ai][bj][m][0] *= r0; acc[ai][bj][m][1] *= r1; }
                asm volatile("" : "+v"(acc[ai][0][m][0]), "+v"(acc[ai][0][m][1]), "+v"(acc[ai][1][m][0]), "+v"(acc[ai][1][m][1]));
                asm volatile("" ::: "memory"); }
    }
    __device__ __forceinline__ void operator()(Acc& acc, const Unit& u, int wr, int wc, int fr, int fq) const {
        asm volatile("" : "+v"(fr), "+v"(fq));
        const int row0 = u.pm * BM + wr * 64 + fr, col0 = u.pn * BM + wc * 32 + 8 * fq;
#pragma unroll
        for (int ai = 0; ai < 2; ++ai)
#pragma unroll
            for (int m = 0; m < 4; ++m) { const size_t off = (size_t)(row0 + ai * HALF + m * 16) * 1024 + col0;
#pragma unroll
                for (int bj = 0; bj < 2; ++bj) { const u32x4 b = *(const u32x4*)(gb + off + bj * HALF);
                    const f32x4 v0 = acc[ai][bj][m][0], v1_ = acc[ai][bj][m][1];
                    u32x4 w; w.x = cvt_pk_bf16(v0[0] * bf_lo(b.x), v0[1] * bf_hi(b.x)); w.y = cvt_pk_bf16(v0[2] * bf_lo(b.y), v0[3] * bf_hi(b.y));
                    w.z = cvt_pk_bf16(v1_[0] * bf_lo(b.z), v1_[1] * bf_hi(b.z)); w.w = cvt_pk_bf16(v1_[2] * bf_lo(b.w), v1_[3] * bf_hi(b.w));
                    *(u32x4*)(out + off + bj * HALF) = w; } }
    }
};

struct EpiResid {
    static constexpr bool PERM = false, HAS_MID = false;
    const float* base; float* out; const float* gvec;
    __device__ __forceinline__ void mid(Acc&, const Unit&, int, int, int, int) const {}
    __device__ __forceinline__ void operator()(Acc& acc, const Unit& u, int wr, int wc, int fr, int fq) const {
        asm volatile("" : "+v"(fr), "+v"(fq));
        const int bidx = (u.pm * BM) / SEQ; const float* gv = gvec + (size_t)bidx * N_MOD6;
        const int row0 = u.pm * BM + wr * 64 + fr, col0 = u.pn * BM + wc * 32 + 4 * fq;
        f32x4 g4[2][2];
#pragma unroll
        for (int bj = 0; bj < 2; ++bj)
#pragma unroll
            for (int n = 0; n < 2; ++n) g4[bj][n] = *(const f32x4*)(gv + col0 + bj * HALF + n * 16);
#pragma unroll
        for (int ai = 0; ai < 2; ++ai)
#pragma unroll
            for (int m = 0; m < 4; ++m) { const size_t off = (size_t)(row0 + ai * HALF + m * 16) * 1024 + col0;
#pragma unroll
                for (int bj = 0; bj < 2; ++bj)
#pragma unroll
                    for (int n = 0; n < 2; ++n) { const f32x4 bs = *(const f32x4*)(base + off + bj * HALF + n * 16);
                        *(f32x4*)(out + off + bj * HALF + n * 16) = bs + g4[bj][n] * acc[ai][bj][m][n]; } }
    }
};

struct EpiSwiglu {
    static constexpr bool PERM = true, HAS_MID = false;
    bf16_t* out;
    __device__ __forceinline__ void mid(Acc&, const Unit&, int, int, int, int) const {}
    __device__ __forceinline__ void operator()(Acc& acc, const Unit& u, int wr, int wc, int fr, int fq) const {
        asm volatile("" : "+v"(fr), "+v"(fq));
        const int row0 = u.pm * BM + wr * 64 + fr, col0 = u.pn * HALF + wc * 32 + 8 * fq;
#pragma unroll
        for (int ai = 0; ai < 2; ++ai)
#pragma unroll
            for (int m = 0; m < 4; ++m) { bf16_t* rowp = out + (size_t)(row0 + ai * HALF + m * 16) * FFN_H + col0;
                float r[8];
#pragma unroll
                for (int n = 0; n < 2; ++n)
#pragma unroll
                    for (int i = 0; i < 4; ++i) { const float g = acc[ai][0][m][n][i], up = acc[ai][1][m][n][i];
                        r[4 * n + i] = g * fast_rcp(1.f + fast_exp2(-1.4426950409f * g)) * up; }
                u32x4 w; w.x = cvt_pk_bf16(r[0], r[1]); w.y = cvt_pk_bf16(r[2], r[3]); w.z = cvt_pk_bf16(r[4], r[5]); w.w = cvt_pk_bf16(r[6], r[7]);
                *(u32x4*)rowp = w; }
    }
};

template <class Epi, class Sched, bool ALIGN_EPI, bool SP2>
__device__ __forceinline__ void gemm_phase(LAS unsigned char* lds, const Gemm g, const Sched& S, const Epi& E) {
    const int tid = fresh_tid(), wid = __builtin_amdgcn_readfirstlane(tid >> 6), lane = tid & 63, wr = wid >> 2, wc = wid & 3, fr = lane & 15, fq = lane >> 4;
    const int K = g.K, nt = K / BK;
    unsigned voffA[2], voffB[2];
#pragma unroll
    for (int i = 0; i < 2; ++i) { int R, C; stage_rc(tid * 16 + i * 8192, R, C); const int Rb = Epi::PERM ? ((R & ~31) + perm32(R & 31)) : R;
        voffA[i] = (unsigned)(R * K + C) * 2u; voffB[i] = (unsigned)(Rb * K + C) * 2u; }
    const size_t kstep = (size_t)(BK * 2);
    const size_t hstep = (size_t)HALF * K * 2;
    const size_t tstep = 2 * hstep;
    const unsigned ldsw = (unsigned)wid * 1024u;
    const int aoff = lds_byte(wr * 64 + fr, fq * 8), boff = lds_byte(wc * 32 + fr, fq * 8);
#define PG8_SA(b, h) (((b) * 2 + (h)) * HTB)
#define PG8_SB(b, h) ((4 + (b) * 2 + (h)) * HTB)
#define PG8_STAGE(bufoff, gbase, voff) do { _Pragma("unroll") for (int _i = 0; _i < 2; ++_i) \
        __builtin_amdgcn_global_load_lds((const unsigned*)((const char*)(gbase) + (voff)[_i]), (LAS unsigned*)(lds + (bufoff) + ldsw + _i * 8192), 16, 0, 0); } while (0)
#define PG8_LDA(dst, b, h) do { _Pragma("unroll") for (int m = 0; m < 4; ++m) _Pragma("unroll") for (int k = 0; k < 2; ++k) dst[m][k] = *(const LAS bf16x8*)(lds + PG8_SA(b, h) + aoff + m * 2048 + k * 1024); } while (0)
#define PG8_LDB(dst, b, h) do { _Pragma("unroll") for (int n = 0; n < 2; ++n) _Pragma("unroll") for (int k = 0; k < 2; ++k) dst[n][k] = *(const LAS bf16x8*)(lds + PG8_SB(b, h) + boff + n * 2048 + k * 1024); } while (0)
#define PG8_MMA(ai, bj, At, Bt) do { __builtin_amdgcn_s_setprio(1); _Pragma("unroll") for (int m = 0; m < 4; ++m) _Pragma("unroll") for (int n = 0; n < 2; ++n) _Pragma("unroll") for (int k = 0; k < 2; ++k) \
        acc[ai][bj][m][n] = __builtin_amdgcn_mfma_f32_16x16x32_bf16(Bt[n][k], At[m][k], acc[ai][bj][m][n], 0, 0, 0); __builtin_amdgcn_s_setprio(0); } while (0)
#define PG8_WAIT_V(n) asm volatile("s_waitcnt vmcnt(" #n ")" ::: "memory")
#define PG8_WAIT_L(n) asm volatile("s_waitcnt lgkmcnt(" #n ")" ::: "memory")
#define PG8_BAR __builtin_amdgcn_s_barrier()
#define PG8_SCHED __builtin_amdgcn_sched_barrier(0)
    Unit cur, nxt; int ui = 0;
    if (!S.next(0, cur)) return;
    Acc acc;
#pragma unroll
    for (int a = 0; a < 2; ++a)
#pragma unroll
        for (int b = 0; b < 2; ++b)
#pragma unroll
            for (int m = 0; m < 4; ++m)
#pragma unroll
                for (int n = 0; n < 2; ++n) acc[a][b][m][n] = (f32x4){0.f, 0.f, 0.f, 0.f};
    bf16x8 At[4][2], B0[2][2], B1[2][2];
    const char* cA = (const char*)g.A + (size_t)cur.pm * tstep; const char* cB = (const char*)g.Bt + (size_t)cur.pn * tstep;
    if constexpr (SP2) {
        PG8_STAGE(PG8_SB(0, 0), cB, voffB); PG8_STAGE(PG8_SB(0, 1), cB + hstep, voffB); PG8_STAGE(PG8_SA(0, 0), cA, voffA); PG8_STAGE(PG8_SA(0, 1), cA + hstep, voffA);
        if (wr == 1) PG8_BAR;
        PG8_WAIT_V(2); PG8_BAR;
        PG8_STAGE(PG8_SB(1, 0), cB + kstep, voffB); PG8_STAGE(PG8_SA(1, 0), cA + kstep, voffA); PG8_STAGE(PG8_SB(1, 1), cB + hstep + kstep, voffB);
        PG8_WAIT_V(6); PG8_BAR;
    } else {
        PG8_STAGE(PG8_SB(0, 0), cB, voffB); PG8_STAGE(PG8_SA(0, 0), cA, voffA); PG8_STAGE(PG8_SB(0, 1), cB + hstep, voffB); PG8_STAGE(PG8_SA(0, 1), cA + hstep, voffA);
        if (wr == 1) PG8_BAR;
        PG8_WAIT_V(4); PG8_BAR;
        PG8_STAGE(PG8_SB(1, 0), cB + kstep, voffB); PG8_STAGE(PG8_SA(1, 0), cA + kstep, voffA); PG8_STAGE(PG8_SB(1, 1), cB + hstep + kstep, voffB);
        PG8_WAIT_V(6); PG8_BAR;
    }
    for (;;) {
        const bool has_next = S.next(ui + 1, nxt);
        const char* nA = has_next ? (const char*)g.A + (size_t)nxt.pm * tstep : cA; const char* nB = has_next ? (const char*)g.Bt + (size_t)nxt.pn * tstep : cB;
        for (int t = 0; t < nt; t += 2) {
            if constexpr (Epi::HAS_MID) { if (t == (nt >> 1)) E.mid(acc, cur, wr, wc, fr, fq); }
            const bool last = (t == nt - 2);
            const char* a1 = cA + (size_t)(t + 1) * kstep;
            const char* a2 = last ? nA : cA + (size_t)(t + 2) * kstep; const char* b2 = last ? nB : cB + (size_t)(t + 2) * kstep;
            const char* a3 = a2 + kstep; const char* b3 = b2 + kstep;
            if constexpr (SP2) {
            PG8_LDB(B0, 0, 0); PG8_LDB(B1, 0, 1); PG8_SCHED; PG8_LDA(At, 0, 0); PG8_STAGE(PG8_SA(1, 1), a1 + hstep, voffA);
            PG8_WAIT_V(8); PG8_WAIT_L(0); PG8_BAR; PG8_MMA(0, 0, At, B0); PG8_MMA(0, 1, At, B1); PG8_BAR; PG8_SCHED;
            PG8_LDA(At, 0, 1); PG8_STAGE(PG8_SB(0, 0), b2, voffB); PG8_STAGE(PG8_SB(0, 1), b2 + hstep, voffB); PG8_STAGE(PG8_SA(0, 0), a2, voffA);
            PG8_WAIT_V(8); PG8_WAIT_L(0); PG8_BAR; PG8_MMA(1, 0, At, B0); PG8_MMA(1, 1, At, B1); PG8_BAR; PG8_SCHED;
            PG8_LDB(B0, 1, 0); PG8_LDB(B1, 1, 1); PG8_SCHED; PG8_LDA(At, 1, 0); PG8_STAGE(PG8_SA(0, 1), a2 + hstep, voffA);
            PG8_WAIT_V(8); PG8_WAIT_L(0); PG8_BAR; PG8_MMA(0, 0, At, B0); PG8_MMA(0, 1, At, B1); PG8_BAR; PG8_SCHED;
            PG8_LDA(At, 1, 1); PG8_STAGE(PG8_SB(1, 0), b3, voffB); PG8_STAGE(PG8_SB(1, 1), b3 + hstep, voffB); PG8_STAGE(PG8_SA(1, 0), a3, voffA);
            PG8_WAIT_V(8); PG8_WAIT_L(0); PG8_BAR; PG8_MMA(1, 0, At, B0); PG8_MMA(1, 1, At, B1); PG8_BAR; PG8_SCHED;
            } else {
            PG8_LDB(B0, 0, 0); PG8_SCHED; PG8_LDA(At, 0, 0); PG8_STAGE(PG8_SA(1, 1), a1 + hstep, voffA);
            PG8_WAIT_L(8); PG8_BAR; PG8_WAIT_L(0); PG8_MMA(0, 0, At, B0); PG8_BAR; PG8_SCHED;
            PG8_LDB(B1, 0, 1); PG8_STAGE(PG8_SB(0, 0), b2, voffB);
            PG8_BAR; PG8_WAIT_L(0); PG8_MMA(0, 1, At, B1); PG8_BAR;
            PG8_LDA(At, 0, 1); PG8_STAGE(PG8_SA(0, 0), a2, voffA);
            PG8_BAR; PG8_WAIT_L(0); PG8_MMA(1, 0, At, B0); PG8_BAR; PG8_SCHED;
            PG8_STAGE(PG8_SB(0, 1), b2 + hstep, voffB);
            PG8_WAIT_V(6); PG8_BAR; PG8_MMA(1, 1, At, B1); PG8_BAR;
            PG8_LDB(B0, 1, 0); PG8_SCHED; PG8_LDA(At, 1, 0); PG8_STAGE(PG8_SA(0, 1), a2 + hstep, voffA);
            PG8_WAIT_L(8); PG8_BAR; PG8_WAIT_L(0); PG8_MMA(0, 0, At, B0); PG8_BAR; PG8_SCHED;
            PG8_LDB(B1, 1, 1); PG8_STAGE(PG8_SB(1, 0), b3, voffB);
            PG8_BAR; PG8_WAIT_L(0); PG8_MMA(0, 1, At, B1); PG8_BAR;
            PG8_LDA(At, 1, 1); PG8_STAGE(PG8_SA(1, 0), a3, voffA);
            PG8_BAR; PG8_WAIT_L(0); PG8_MMA(1, 0, At, B0); PG8_BAR; PG8_SCHED;
            PG8_STAGE(PG8_SB(1, 1), b3 + hstep, voffB);
            PG8_WAIT_V(6); PG8_BAR; PG8_MMA(1, 1, At, B1); PG8_BAR;
            }
        }
        if constexpr (ALIGN_EPI) { if (wr == 0) PG8_BAR; }
        E(acc, cur, wr, wc, fr, fq);
        if (!has_next) break;
#pragma unroll
        for (int a = 0; a < 2; ++a)
#pragma unroll
            for (int b = 0; b < 2; ++b)
#pragma unroll
                for (int m = 0; m < 4; ++m)
#pragma unroll
                    for (int n = 0; n < 2; ++n) acc[a][b][m][n] = (f32x4){0.f, 0.f, 0.f, 0.f};
        cur = nxt; cA = nA; cB = nB; ++ui;
        if constexpr (ALIGN_EPI) { if (wr == 1) PG8_BAR; }
    }
    PG8_WAIT_V(0);
    if constexpr (!ALIGN_EPI) { if (wr == 0) PG8_BAR; }
    PG8_BAR;
#undef PG8_SA
#undef PG8_SB
#undef PG8_STAGE
#undef PG8_LDA
#undef PG8_LDB
#undef PG8_MMA
#undef PG8_WAIT_V
#undef PG8_WAIT_L
#undef PG8_BAR
#undef PG8_SCHED
}
}

constexpr size_t MiB = 1u << 20;
constexpr size_t WS_MODP = 0;
constexpr size_t WS_MODF = 1536 * 1024;
constexpr size_t WS_KPART = WS_MODF + 128 * 1024;
constexpr size_t WS_WSP = WS_KPART + 512 * 1024;
constexpr size_t WS_CTL = 2560 * 1024;
constexpr size_t WS_WIN = 3 * MiB;
constexpr size_t WS_WAB = 17 * MiB;
constexpr size_t WS_WOUT = 21 * MiB;
constexpr size_t WS_WGU = 23 * MiB;
constexpr size_t WS_WD = 34 * MiB;
constexpr size_t WS_H = 40 * MiB;
constexpr size_t WS_YCAT = 72 * MiB;
constexpr size_t WS_K = 136 * MiB;
constexpr size_t WS_VV = 168 * MiB;
constexpr size_t WS_V1 = 200 * MiB;
constexpr size_t WS_END = 232 * MiB;
static_assert(WS_WSP + 256 * 1024 <= WS_WIN && WS_WD + (size_t)1024 * 2816 * 2 <= WS_H && WS_YCAT + (size_t)M_TOK * FFN_H * 2 <= WS_VV, "ws map");

constexpr int LDS_BYTES = 147456;
constexpr int NPHASE = 10;
constexpr int MISC_OFF = 139264;

__device__ __forceinline__ void p0_transpose_item(const float* W, int N, bf16_t* WT, int dpitch, int dkoff, int drow0, int kb, int nb, LAS float* scr, int lane) {
    const int k0 = 64 * kb, n0 = 32 * nb;
#pragma unroll 8
    for (int i = 0; i < 32; ++i) { const int kk = 2 * i + (lane >> 5); scr[kk * 33 + (lane & 31)] = W[(size_t)(k0 + kk) * N + n0 + (lane & 31)]; }
    asm volatile("s_waitcnt lgkmcnt(0)" ::: "memory");
    const int c = lane & 7;
#pragma unroll
    for (int j = 0; j < 4; ++j) { const int n = (lane >> 3) + 8 * j; const LAS float* s = scr + (8 * c) * 33 + n;
        u32x4 o; o.x = cvt_pk_bf16(s[0 * 33], s[1 * 33]); o.y = cvt_pk_bf16(s[2 * 33], s[3 * 33]); o.z = cvt_pk_bf16(s[4 * 33], s[5 * 33]); o.w = cvt_pk_bf16(s[6 * 33], s[7 * 33]);
        *(u32x4*)(WT + (size_t)(drow0 + n) * dpitch + dkoff + k0 + 8 * c) = o; }
    asm volatile("s_waitcnt lgkmcnt(0)" ::: "memory");
}

template <bool OUT_BF16>
__device__ __forceinline__ void rms_row(const float* xrow, const LAS float* Av, const LAS float* Bv, void* orow, int lane) {
    const f32x4* xr = (const f32x4*)xrow + lane;
    f32x4 v[4]; float s = 0.f;
#pragma unroll
    for (int j = 0; j < 4; ++j) { v[j] = xr[64 * j]; s += (v[j].x * v[j].x + v[j].y * v[j].y) + (v[j].z * v[j].z + v[j].w * v[j].w); }
    const float rstd = 1.0f / sqrtf(wave_sum(s) * (1.f / D_MODEL) + EPS);
#pragma unroll
    for (int j = 0; j < 4; ++j) {
        const f32x4 a = *(const LAS f32x4*)(Av + 4 * lane + 256 * j); f32x4 y = v[j] * rstd * a;
        if (Bv) y += *(const LAS f32x4*)(Bv + 4 * lane + 256 * j);
        if (OUT_BF16) { u32x2 w; w.x = cvt_pk_bf16(y.x, y.y); w.y = cvt_pk_bf16(y.z, y.w); *((u32x2*)orow + lane + 64 * j) = w; }
        else *((f32x4*)orow + lane + 64 * j) = y;
    }
}

__device__ __forceinline__ unsigned off_b(unsigned row, unsigned ch) { return 256u * row + 16u * (ch ^ (((row & 3u) << 2) | ((row >> 2) & 3u))); }
__device__ __forceinline__ unsigned tr_addr(unsigned lane, unsigned c, unsigned ks, unsigned t) {
    const unsigned h = lane >> 5, blk = (lane >> 4) & 1, q = (lane & 15) >> 2, p = lane & 3;
    return off_b(16 * ks + 8 * h + 4 * t + q, 4 * c + 2 * blk + (p >> 1)) + 8 * (p & 1);
}
__device__ __forceinline__ s16x4 tr_read(const LAS unsigned char* p) { return __builtin_bit_cast(s16x4, __builtin_amdgcn_ds_read_tr16_b64_v4i16((LAS s16x4*)p)); }
__device__ __forceinline__ bf16x8 tr_pair(const LAS unsigned char* base, unsigned lane, unsigned c, unsigned ks) {
    const s16x4 lo = tr_read(base + tr_addr(lane, c, ks, 0)), hi = tr_read(base + tr_addr(lane, c, ks, 1));
    return (bf16x8){lo[0], lo[1], lo[2], lo[3], hi[0], hi[1], hi[2], hi[3]};
}

__device__ __forceinline__ void attn_unit(LAS unsigned char* lds, int b, int h, int qblk, bf16_t* ycat, const bf16_t* Kb, const bf16_t* Vb, const float* kpart) {
    const int tid = fresh_tid(), lane = tid & 63, w = __builtin_amdgcn_readfirstlane(tid >> 6), q = lane & 31, hi = lane >> 5;
    const size_t rowbase = (size_t)b * SEQ;
    LAS float* kbar = (LAS float*)(lds + 65536);
    const unsigned qoff = (unsigned)((rowbase + (size_t)qblk * 256 + 32 * w + q) * 2048 + 1024 + h * 128);
#define Qp (ycat + qoff)
    bf16x8 qr[8];
#pragma unroll
    for (int s = 0; s < 8; ++s) qr[s] = *(const bf16x8*)(Qp + 16 * s + 8 * hi);
    for (int idx = tid; idx < qblk * 128; idx += 512) { const int j = idx >> 7, d = idx & 127; const float* kp = kpart + (size_t)((b * 16 + j) * 2) * 1024 + h * 128 + d; kbar[idx] = (kp[0] + kp[1024]) * (1.f / 256.f); }
    __syncthreads();
    float t1 = -3.0e38f, t2 = -3.0e38f, t3 = -3.0e38f; unsigned b1 = 0u, b2 = 0u, b3 = 0u;
#pragma unroll 1
    for (int j = 0; j < qblk; ++j) {
        float s0 = 0.f, s1 = 0.f;
#pragma unroll
        for (int s = 0; s < 8; ++s) {
            const f32x4 k0 = *(const LAS f32x4*)(kbar + j * 128 + 16 * s + 8 * hi), k1 = *(const LAS f32x4*)(kbar + j * 128 + 16 * s + 8 * hi + 4);
            const u32x4 qw = __builtin_bit_cast(u32x4, qr[s]);
            s0 += bf_lo(qw.x) * k0[0]; s1 += bf_hi(qw.x) * k0[1]; s0 += bf_lo(qw.y) * k0[2]; s1 += bf_hi(qw.y) * k0[3];
            s0 += bf_lo(qw.z) * k1[0]; s1 += bf_hi(qw.z) * k1[1]; s0 += bf_lo(qw.w) * k1[2]; s1 += bf_hi(qw.w) * k1[3];
        }
        const float part = s0 + s1;
        const float gj = part + __shfl_xor(part, 32);
        const unsigned bj = 1u << j;
        const bool c1 = gj > t1, c2 = gj > t2, c3 = gj > t3;
        t3 = c2 ? t2 : (c3 ? gj : t3); b3 = c2 ? b2 : (c3 ? bj : b3);
        t2 = c1 ? t1 : (c2 ? gj : t2); b2 = c1 ? b1 : (c2 ? bj : b2);
        t1 = c1 ? gj : t1;             b1 = c1 ? bj : b1;
    }
    const unsigned sel = b1 | b2 | b3;
    const int srow = tid >> 3, sch = (tid & 7) * 2;
    const unsigned st_off0 = (unsigned)(srow >> 5) * 8192u + off_b(srow & 31, sch), st_off1 = (unsigned)(srow >> 5) * 8192u + off_b(srow & 31, sch + 1);
    const unsigned kvoff = (unsigned)((rowbase + srow) * 1024 + h * 128 + sch * 8);
    const int NT = 4 * (qblk + 1);
    u32x4 kr0, kr1, vr0, vr1;
#define KVROW(ti) ((ti) < 4 ? (unsigned)qblk * 256u + 64u * (unsigned)(ti) : (unsigned)((ti) - 4) * 64u)
#define LOADT(ti) do { const unsigned ro_ = kvoff + KVROW(ti) * 1024u; kr0 = *(const u32x4*)(Kb + ro_); kr1 = *(const u32x4*)(Kb + ro_ + 8); vr0 = *(const u32x4*)(Vb + ro_); vr1 = *(const u32x4*)(Vb + ro_ + 8); } while (0)
#define STORET(buf) do { LAS unsigned char* kb_ = lds + (buf) * 32768; *(LAS u32x4*)(kb_ + st_off0) = kr0; *(LAS u32x4*)(kb_ + st_off1) = kr1; *(LAS u32x4*)(kb_ + 16384 + st_off0) = vr0; *(LAS u32x4*)(kb_ + 16384 + st_off1) = vr1; } while (0)
    LOADT(0); STORET(0);
    __syncthreads();
    const unsigned pr = (unsigned)((q & 19) | ((q & 4) << 1) | ((q & 8) >> 1));
    const unsigned kx = ((pr & 3u) << 2) | ((pr >> 2) & 3u), krow = 256u * pr;
    float m_run = NEGB, l_run = 0.f;
    f32x16 o[4];
#pragma unroll
    for (int c = 0; c < 4; ++c)
#pragma unroll
        for (int r = 0; r < 16; ++r) o[c][r] = 0.f;
    for (int ti = 0; ti < NT; ++ti) {
        const bool more = (ti + 1 < NT);
        if (more) LOADT(ti + 1);
        __builtin_amdgcn_sched_barrier(0);
        const LAS unsigned char* Kt = lds + (ti & 1) * 32768; const LAS unsigned char* Vt = Kt + 16384;
        const bool own = ti < 4;
        bool lane_on = true, active = true;
        if (own) active = (w >= 2 * ti);
        else { lane_on = ((sel >> ((ti - 4) >> 2)) & 1u) != 0u; active = __any(lane_on) != 0; }
        if (active) {
            unsigned kx_ = kx, ln_ = (unsigned)lane;
            asm volatile("" : "+v"(kx_), "+v"(ln_));
            f32x16 p0, p1;
#pragma unroll
            for (int r = 0; r < 16; ++r) { p0[r] = 0.f; p1[r] = 0.f; }
#pragma unroll
            for (int s = 0; s < 8; ++s) {
                const unsigned ka = krow + 16u * ((unsigned)(2 * s + hi) ^ kx_);
                const bf16x8 a0 = *(const LAS bf16x8*)(Kt + ka), a1 = *(const LAS bf16x8*)(Kt + 8192 + ka);
                p0 = __builtin_amdgcn_mfma_f32_32x32x16_bf16(a0, qr[s], p0, 0, 0, 0);
                p1 = __builtin_amdgcn_mfma_f32_32x32x16_bf16(a1, qr[s], p1, 0, 0, 0);
                if (s & 1) __builtin_amdgcn_sched_barrier(0);
            }
            if (own) {
                if (w < 2 * ti + 2) { const int basek = 64 * ti + 8 * hi - (32 * w + q);
#pragma unroll
                    for (int r = 0; r < 16; ++r) { const int dk = basek + 16 * (r >> 3) + (r & 7); if (dk > 0) p0[r] = NEGB; if (dk + 32 > 0) p1[r] = NEGB; } }
            } else if (!lane_on) {
#pragma unroll
                for (int r = 0; r < 16; ++r) { p0[r] = NEGB; p1[r] = NEGB; }
            }
            float mx = fmaxf(p0[0], p1[0]);
#pragma unroll
            for (int r = 1; r < 16; ++r) mx = fmaxf(mx, fmaxf(p0[r], p1[r]));
            mx = fmaxf(mx, __shfl_xor(mx, 32));
            const float mn = fmaxf(m_run, mx), alpha = fast_exp2(m_run - mn);
            m_run = mn;
            float rs = 0.f;
#pragma unroll
            for (int r = 0; r < 16; ++r) { p0[r] = fast_exp2(p0[r] - mn); p1[r] = fast_exp2(p1[r] - mn); rs += p0[r] + p1[r]; }
            l_run = l_run * alpha + rs;
            if (__any(alpha != 1.0f)) {
#pragma unroll
                for (int c = 0; c < 4; ++c)
#pragma unroll
                    for (int r = 0; r < 16; ++r) o[c][r] *= alpha;
            }
            bf16x8 pk[4];
            { u32x4 t0, t1, t2, t3;
              t0.x = cvt_pk_bf16(p0[0], p0[1]); t0.y = cvt_pk_bf16(p0[2], p0[3]); t0.z = cvt_pk_bf16(p0[4], p0[5]); t0.w = cvt_pk_bf16(p0[6], p0[7]);
              t1.x = cvt_pk_bf16(p0[8], p0[9]); t1.y = cvt_pk_bf16(p0[10], p0[11]); t1.z = cvt_pk_bf16(p0[12], p0[13]); t1.w = cvt_pk_bf16(p0[14], p0[15]);
              t2.x = cvt_pk_bf16(p1[0], p1[1]); t2.y = cvt_pk_bf16(p1[2], p1[3]); t2.z = cvt_pk_bf16(p1[4], p1[5]); t2.w = cvt_pk_bf16(p1[6], p1[7]);
              t3.x = cvt_pk_bf16(p1[8], p1[9]); t3.y = cvt_pk_bf16(p1[10], p1[11]); t3.z = cvt_pk_bf16(p1[12], p1[13]); t3.w = cvt_pk_bf16(p1[14], p1[15]);
              pk[0] = __builtin_bit_cast(bf16x8, t0); pk[1] = __builtin_bit_cast(bf16x8, t1); pk[2] = __builtin_bit_cast(bf16x8, t2); pk[3] = __builtin_bit_cast(bf16x8, t3); }
            __builtin_amdgcn_sched_barrier(0);
#pragma unroll
            for (int c = 0; c < 4; ++c) {
#pragma unroll
                for (int ks = 0; ks < 4; ++ks) {
                    const bf16x8 vf = tr_pair(Vt + (ks >> 1) * 8192, ln_, (unsigned)c, (unsigned)(ks & 1));
                    o[c] = __builtin_amdgcn_mfma_f32_32x32x16_bf16(vf, pk[ks], o[c], 0, 0, 0);
                }
                __builtin_amdgcn_sched_barrier(0);
            }
        }
        __builtin_amdgcn_sched_barrier(0);
        if (more) STORET((ti + 1) & 1);
        __syncthreads();
    }
#undef KVROW
#undef LOADT
#undef STORET
    const float lt = l_run + __shfl_xor(l_run, 32), inv = 1.0f / lt;
#pragma unroll
    for (int c = 0; c < 4; ++c)
#pragma unroll
        for (int g4 = 0; g4 < 4; ++g4) {
            u32x2 wv; wv.x = cvt_pk_bf16(o[c][4 * g4] * inv, o[c][4 * g4 + 1] * inv); wv.y = cvt_pk_bf16(o[c][4 * g4 + 2] * inv, o[c][4 * g4 + 3] * inv);
            *(u32x2*)(Qp + 32 * c + 8 * g4 + 4 * hi) = wv;
        }
#undef Qp
}

__device__ __forceinline__ void gmlp_unit(LAS unsigned char* lds, int b, int chunk, int gh, bf16_t* ycat, const bf16_t* V1, const bf16_t* Wsp, const float* ln_g, const float* ln_b, const float* b_sp) {
    const int tid = fresh_tid(), lane = tid & 63, w = __builtin_amdgcn_readfirstlane(tid >> 6), hi = lane >> 5;
    const size_t R0 = (size_t)b * SEQ + (size_t)chunk * 128;
    LAS unsigned char* VN = lds;
    LAS unsigned char* WS = lds + 32768;
    LAS float* stats = (LAS float*)(lds + 65536);
#pragma unroll 1
    for (int i0 = 0; i0 < 16; i0 += 8) {
        u32x4 ra[8], rc[8];
#pragma unroll
        for (int i = 0; i < 8; ++i) { const bf16_t* vr = V1 + (R0 + 16 * w + i0 + i) * 1024; ra[i] = *(const u32x4*)(vr + lane * 8); rc[i] = *(const u32x4*)(vr + 512 + lane * 8); }
#pragma unroll
        for (int i = 0; i < 8; ++i) {
            const int row = 16 * w + i0 + i; const u32x4 a = ra[i], c = rc[i];
            float x[16];
            x[0] = bf_lo(a.x); x[1] = bf_hi(a.x); x[2] = bf_lo(a.y); x[3] = bf_hi(a.y); x[4] = bf_lo(a.z); x[5] = bf_hi(a.z); x[6] = bf_lo(a.w); x[7] = bf_hi(a.w);
            x[8] = bf_lo(c.x); x[9] = bf_hi(c.x); x[10] = bf_lo(c.y); x[11] = bf_hi(c.y); x[12] = bf_lo(c.z); x[13] = bf_hi(c.z); x[14] = bf_lo(c.w); x[15] = bf_hi(c.w);
            float s = 0.f;
#pragma unroll
            for (int k = 0; k < 16; ++k) s += x[k];
            const float mean = wave_sum(s) * (1.f / 1024.f);
            float s2 = 0.f;
#pragma unroll
            for (int k = 0; k < 16; ++k) { const float d = x[k] - mean; s2 += d * d; }
            const float rstd = 1.0f / sqrtf(wave_sum(s2) * (1.f / 1024.f) + EPS);
            if (lane == 0) { stats[2 * row] = mean; stats[2 * row + 1] = rstd; }
        }
    }
    __syncthreads();
    const int wt = w & 3, wd = w >> 2, tl = lane & 31;
    const int ch = tid & 15;
    for (int gi = 0; gi < 4; ++gi) {
        const int g = 4 * gh + gi;
        const f32x4 lg0 = *(const f32x4*)(ln_g + g * 128 + ch * 8), lg1 = *(const f32x4*)(ln_g + g * 128 + ch * 8 + 4);
        const f32x4 lb0 = *(const f32x4*)(ln_b + g * 128 + ch * 8), lb1 = *(const f32x4*)(ln_b + g * 128 + ch * 8 + 4);
#pragma unroll
        for (int i = 0; i < 4; ++i) {
            const int row = (tid >> 4) + 32 * i;
            const u32x4 a = *(const u32x4*)(V1 + (R0 + row) * 1024 + g * 128 + ch * 8);
            const float mean = stats[2 * row], rstd = stats[2 * row + 1];
            f32x4 x0 = (f32x4){bf_lo(a.x), bf_hi(a.x), bf_lo(a.y), bf_hi(a.y)}, x1 = (f32x4){bf_lo(a.z), bf_hi(a.z), bf_lo(a.w), bf_hi(a.w)};
            x0 = (x0 - mean) * rstd * lg0 + lb0; x1 = (x1 - mean) * rstd * lg1 + lb1;
            u32x4 o; o.x = cvt_pk_bf16(x0[0], x0[1]); o.y = cvt_pk_bf16(x0[2], x0[3]); o.z = cvt_pk_bf16(x1[0], x1[1]); o.w = cvt_pk_bf16(x1[2], x1[3]);
            *(LAS u32x4*)(VN + (row >> 5) * 8192 + off_b(row & 31, ch)) = o;
            const u32x4 wv = *(const u32x4*)(Wsp + ((size_t)g * 128 + row) * 128 + ch * 8);
            *(LAS u32x4*)(WS + (row >> 5) * 8192 + off_b(row & 31, ch)) = wv;
        }
        __syncthreads();
        f32x16 acc[2];
#pragma unroll
        for (int c = 0; c < 2; ++c)
#pragma unroll
            for (int r = 0; r < 16; ++r) acc[c][r] = 0.f;
#pragma unroll
        for (int ks = 0; ks < 8; ++ks) {
            if (ks <= 2 * wt + 1) {
                const bf16x8 wf = *(const LAS bf16x8*)(WS + wt * 8192 + off_b(tl, 2 * ks + hi));
#pragma unroll
                for (int c = 0; c < 2; ++c) {
                    const bf16x8 vf = tr_pair(VN + (ks >> 1) * 8192, (unsigned)lane, (unsigned)(2 * wd + c), (unsigned)(ks & 1));
                    acc[c] = __builtin_amdgcn_mfma_f32_32x32x16_bf16(vf, wf, acc[c], 0, 0, 0);
                }
            }
        }
        const int t = 32 * wt + tl; const float bs = b_sp[g * 128 + t];
        bf16_t* up = ycat + (R0 + t) * 2048 + g * 128 + 64 * wd + 4 * hi;
#pragma unroll
        for (int c = 0; c < 2; ++c)
#pragma unroll
            for (int g4 = 0; g4 < 4; ++g4) {
                u32x2* p = (u32x2*)(up + 32 * c + 8 * g4); const u32x2 uu = *p;
                u32x2 wv; wv.x = cvt_pk_bf16(bf_lo(uu.x) * (acc[c][4 * g4] + bs), bf_hi(uu.x) * (acc[c][4 * g4 + 1] + bs));
                wv.y = cvt_pk_bf16(bf_lo(uu.y) * (acc[c][4 * g4 + 2] + bs), bf_hi(uu.y) * (acc[c][4 * g4 + 3] + bs));
                *p = wv;
            }
        __syncthreads();
    }
}


#define XB_TMO      128
#define XB_XCNT(j)  (256  + 64 * (j))
#define XB_XSUB(j)  (1280 + 64 * (j))
#define XB_XGEN(j)  (2304 + 64 * (j))
#define XB_TOP      3328
#define XB_TOPGEN   3392
#define XCD_BAR_WORDS 3456
#define XB_SPIN_CAP (1u << 18)
__device__ __forceinline__ unsigned xb_ld(unsigned* p)              { return __hip_atomic_load(p, __ATOMIC_RELAXED, __HIP_MEMORY_SCOPE_AGENT); }
__device__ __forceinline__ unsigned xb_add(unsigned* p, unsigned v) { return __hip_atomic_fetch_add(p, v, __ATOMIC_RELAXED, __HIP_MEMORY_SCOPE_AGENT); }
__device__ __forceinline__ unsigned xb_xcc_id() { return (unsigned)__builtin_amdgcn_s_getreg((3 << 11) | 20) & 0xFu; }
#define XB_SPIN(cond, bar) do { unsigned _sp = 0; while (cond) { __builtin_amdgcn_s_sleep(1); \
    if ((++_sp & 255u) == 0u) { if (xb_ld(&(bar)[XB_TMO])) break; if (_sp > XB_SPIN_CAP) { atomicAdd(&(bar)[XB_TMO], 1u); break; } } } } while (0)
struct XcdBarrier { unsigned* bar; unsigned x; volatile LAS unsigned* st; };
__device__ __forceinline__ XcdBarrier xcd_barrier_post(unsigned* bar, volatile LAS unsigned* st) {
    XcdBarrier b; b.bar = bar; b.x = xb_xcc_id(); b.st = st;
    if (threadIdx.x == 0) (void)xb_add(&bar[XB_XCNT(b.x)], 1u);
    return b;
}
__device__ __forceinline__ void xcd_barrier_complete(unsigned* bar, unsigned x, unsigned& nloc, unsigned& nx) {
    const unsigned G = gridDim.x * gridDim.y * gridDim.z;
    unsigned sum, cnt, mine, sp = 0u;
    for (;;) {
        sum = 0u; cnt = 0u; mine = 0u;
#pragma unroll
        for (unsigned j = 0; j < 16; ++j) { const unsigned c = xb_ld(&bar[XB_XCNT(j)]); sum += c; cnt += (c > 0u) ? 1u : 0u; mine = (j == x) ? c : mine; }
        if (sum == G) break;
        __builtin_amdgcn_s_sleep(1);
        if ((++sp & 255u) == 0u) { if (xb_ld(&bar[XB_TMO])) break; if (sp > XB_SPIN_CAP) { atomicAdd(&bar[XB_TMO], 1u); break; } }
    }
    nloc = mine > 0u ? mine : 1u; nx = cnt > 0u ? cnt : 1u;
}
__device__ __forceinline__ void xcd_barrier(const XcdBarrier& b) {
    asm volatile("s_waitcnt vmcnt(0)" ::: "memory");
    __syncthreads();
    if (threadIdx.x == 0) {
        unsigned* bar = b.bar;
        __builtin_amdgcn_s_waitcnt(0);
        unsigned nloc = b.st[0], nx = b.st[1];
        if (nloc == 0u) { xcd_barrier_complete(bar, b.x, nloc, nx); b.st[0] = nloc; b.st[1] = nx; }
        const unsigned old = xb_add(&bar[XB_XSUB(b.x)], 1u);
        const unsigned gen = old / nloc;
        if (old + 1u == (gen + 1u) * nloc) {
            __builtin_amdgcn_fence(__ATOMIC_RELEASE, "agent");
            asm volatile("s_waitcnt vmcnt(0)" ::: "memory");
            const unsigned og = xb_add(&bar[XB_TOP], 1u);
            const unsigned tg = og / nx;
            if (og + 1u == (tg + 1u) * nx) xb_add(&bar[XB_TOPGEN], 1u);
            else XB_SPIN(xb_ld(&bar[XB_TOPGEN]) == tg, bar);
            __builtin_amdgcn_fence(__ATOMIC_ACQUIRE, "agent");
            xb_add(&bar[XB_XGEN(b.x)], 1u);
            asm volatile("s_waitcnt vmcnt(0)" ::: "memory");
        } else {
            XB_SPIN(xb_ld(&bar[XB_XGEN(b.x)]) == gen, bar);
            __builtin_amdgcn_fence(__ATOMIC_ACQUIRE, "agent");
            asm volatile("s_waitcnt vmcnt(0)" ::: "memory");
        }
    }
    __syncthreads();
}

struct Args { const float* in[18]; float* out; unsigned char* ws; int ph_lo, ph_hi; };

__global__ void __launch_bounds__(512, 2) fwd_megakernel(Args args) {
    extern __shared__ __attribute__((aligned(16))) unsigned char lds_raw[];
    LAS unsigned char* lds = (LAS unsigned char*)lds_raw;
    const int G = gridDim.x, bx = blockIdx.x;
    const int vcu = (G % 8 == 0) ? (bx % 8) * (G / 8) + bx / 8 : bx;
    const int lo = args.ph_lo, hi = args.ph_hi;
    unsigned char* ws = args.ws;
    const float* x = args.in[0]; const float* cvec = args.in[1]; const float* w_ada = args.in[2]; const float* b_ada = args.in[3];
    const float* norm_mix_g = args.in[4]; const float* w_in = args.in[5]; const float* ln_v_g = args.in[6]; const float* ln_v_b = args.in[7];
    const float* w_spatial = args.in[8]; const float* b_spatial = args.in[9]; const float* w_proj_a = args.in[10]; const float* w_proj_b = args.in[11];
    const float* w_out = args.in[12]; const float* norm_ffn_g = args.in[13]; const float* w_ffn_gate = args.in[14]; const float* w_ffn_up = args.in[15];
    const float* w_ffn_down = args.in[16]; const float* norm_final_g = args.in[17];
    float* out = args.out;
    float* modp = (float*)(ws + WS_MODP); float* modf = (float*)(ws + WS_MODF); float* kpart = (float*)(ws + WS_KPART);
    bf16_t* Wsp = (bf16_t*)(ws + WS_WSP); bf16_t* Win_t = (bf16_t*)(ws + WS_WIN); bf16_t* Wab_t = (bf16_t*)(ws + WS_WAB); bf16_t* Wout_t = (bf16_t*)(ws + WS_WOUT);
    bf16_t* Wgu_t = (bf16_t*)(ws + WS_WGU); bf16_t* Wd_t = (bf16_t*)(ws + WS_WD);
    bf16_t* Hb = (bf16_t*)(ws + WS_H); bf16_t* Ycat = (bf16_t*)(ws + WS_YCAT); bf16_t* Kbuf = (bf16_t*)(ws + WS_K); bf16_t* Vbuf = (bf16_t*)(ws + WS_VV); bf16_t* V1 = (bf16_t*)(ws + WS_V1);
    bf16_t* Merged = Hb; bf16_t* H2 = V1; bf16_t* HF = Ycat;
    bf16_t* GA = (bf16_t*)out; bf16_t* GB = GA + (size_t)M_TOK * 1024;
    cg::grid_group grid = cg::this_grid();
    volatile LAS unsigned* MISC = (volatile LAS unsigned*)(lds + MISC_OFF);
    if (threadIdx.x < 16) MISC[threadIdx.x] = 0u;
    __syncthreads();
    XcdBarrier bar; bar.bar = (unsigned*)(ws + WS_CTL); bar.x = 0; bar.st = MISC;
    if (hi - lo > 1) bar = xcd_barrier_post((unsigned*)(ws + WS_CTL), MISC);
    if (hi > 1000) grid.sync();
#define IN(k) (lo <= (k) && (k) < hi)
#define SEAM(k) do { if (IN(k) && IN((k) + 1)) xcd_barrier(bar); } while (0)

    if (IN(0)) {
        const int tid = fresh_tid(), lane = tid & 63, wave = __builtin_amdgcn_readfirstlane(tid >> 6);
        LAS float* scr = (LAS float*)(lds + wave * 16384);
        const int gw = vcu * 8 + wave, NGW = G * 8;
        constexpr int I_IN = 16 * 224, I_P = 16 * 32, I_F = 16 * 88, I_D = 44 * 32;
        constexpr int NITEMS = I_IN + 3 * I_P + 2 * I_F + I_D;
        for (int it = gw; it < NITEMS; it += NGW) {
            int r = it;
            if (r < I_IN) { p0_transpose_item(w_in, IN_WIDTH, Win_t, 1024, 0, 32 * (r % 224), r / 224, r % 224, scr, lane); continue; } r -= I_IN;
            if (r < I_P) { p0_transpose_item(w_proj_a, 1024, Wab_t, 2048, 0, 32 * (r % 32), r / 32, r % 32, scr, lane); continue; } r -= I_P;
            if (r < I_P) { p0_transpose_item(w_proj_b, 1024, Wab_t, 2048, 1024, 32 * (r % 32), r / 32, r % 32, scr, lane); continue; } r -= I_P;
            if (r < I_P) { p0_transpose_item(w_out, 1024, Wout_t, 1024, 0, 32 * (r % 32), r / 32, r % 32, scr, lane); continue; } r -= I_P;
            if (r < I_F) { const int nb = r % 88, n0 = 32 * nb; p0_transpose_item(w_ffn_gate, FFN_H, Wgu_t, 1024, 0, (n0 >> 7) * 256 + (n0 & 127), r / 88, nb, scr, lane); continue; } r -= I_F;
            if (r < I_F) { const int nb = r % 88, n0 = 32 * nb; p0_transpose_item(w_ffn_up, FFN_H, Wgu_t, 1024, 0, (n0 >> 7) * 256 + 128 + (n0 & 127), r / 88, nb, scr, lane); continue; } r -= I_F;
            p0_transpose_item(w_ffn_down, 1024, Wd_t, FFN_H, 0, 32 * (r % 32), r / 32, r % 32, scr, lane);
        }
        { const int gt = (vcu * 512 + tid);
          if (gt < 16384) { const int e0 = gt * 8, t = (e0 >> 7) & 127, s0 = e0 & 127;
              const f32x4 a = *(const f32x4*)(w_spatial + e0), c = *(const f32x4*)(w_spatial + e0 + 4);
              float v[8] = {a[0], a[1], a[2], a[3], c[0], c[1], c[2], c[3]};
#pragma unroll
              for (int k = 0; k < 8; ++k) if (s0 + k > t) v[k] = 0.f;
              u32x4 o; o.x = cvt_pk_bf16(v[0], v[1]); o.y = cvt_pk_bf16(v[2], v[3]); o.z = cvt_pk_bf16(v[4], v[5]); o.w = cvt_pk_bf16(v[6], v[7]);
              *(u32x4*)(Wsp + e0) = o; } }
        for (int it = gw; it < 96 * 16; it += NGW) {
            const int jg = it % 96, kc = it / 96, j = jg * 64 + lane, k0 = kc * 64;
            float cv[4], ac[4];
#pragma unroll
            for (int bb = 0; bb < 4; ++bb) { const float c = cvec[bb * 1024 + k0 + lane]; cv[bb] = c / (1.f + __expf(-c)); ac[bb] = 0.f; }
#pragma unroll 16
            for (int kk = 0; kk < 64; ++kk) {
                const float wv = w_ada[(size_t)(k0 + kk) * N_MOD6 + j];
#pragma unroll
                for (int bb = 0; bb < 4; ++bb) ac[bb] += __uint_as_float(__builtin_amdgcn_readlane(__float_as_uint(cv[bb]), kk)) * wv;
            }
#pragma unroll
            for (int bb = 0; bb < 4; ++bb) modp[(size_t)(kc * 4 + bb) * N_MOD6 + j] = ac[bb];
        }
    }
    SEAM(0);

    if (IN(1)) {
        const int tid = fresh_tid(), lane = tid & 63, wave = __builtin_amdgcn_readfirstlane(tid >> 6);
        LAS float* Av = (LAS float*)lds; LAS float* Bv = Av + 1024;
        for (int chk = bx; chk < 256; chk += G) {
            const int b = chk >> 6;
            for (int c = tid; c < 1024; c += 512) {
                float sh = b_ada[c], sc = b_ada[1024 + c];
#pragma unroll
                for (int kc = 0; kc < 16; ++kc) { sh += modp[(size_t)(kc * 4 + b) * N_MOD6 + c]; sc += modp[(size_t)(kc * 4 + b) * N_MOD6 + 1024 + c]; }
                Av[c] = norm_mix_g[c] * (1.f + sc); Bv[c] = sh;
            }
            if (tid < 96) { const int idx = chk * 96 + tid, bb = idx / N_MOD6, j = idx % N_MOD6; float s = b_ada[j];
#pragma unroll
                for (int kc = 0; kc < 16; ++kc) s += modp[(size_t)(kc * 4 + bb) * N_MOD6 + j];
                modf[idx] = s; }
            __syncthreads();
            for (int i = 0; i < 8; ++i) { const size_t row = (size_t)chk * 64 + wave * 8 + i; rms_row<true>(x + row * 1024, Av, Bv, Hb + row * 1024, lane); }
            __syncthreads();
        }
    }
    SEAM(1);

    if (IN(2)) {
        pg8::Gemm g{Hb, Win_t, M_TOK, IN_WIDTH, 1024}; pg8::StaticOrder S; S.init(M_TOK, IN_WIDTH, G, bx);
        pg8::EpiIn E{Ycat, V1, Kbuf, Vbuf, GA, GB, kpart};
        pg8::gemm_phase<pg8::EpiIn, pg8::StaticOrder, true, true>(lds, g, S, E);
    }
    SEAM(2);

    if (IN(3)) {
        for (int v = vcu; v < 256; v += G) {
            const int bh = v >> 3, s = v & 7;
            attn_unit(lds, bh >> 3, bh & 7, 15 - s, Ycat, Kbuf, Vbuf, kpart);
            attn_unit(lds, bh >> 3, bh & 7, s, Ycat, Kbuf, Vbuf, kpart);
            gmlp_unit(lds, v >> 6, (v >> 1) & 31, v & 1, Ycat, V1, Wsp, ln_v_g, ln_v_b, b_spatial);
        }
    }
    SEAM(3);

    if (IN(4)) {
        pg8::Gemm g{Ycat, Wab_t, M_TOK, 1024, 2048}; pg8::StaticOrder S; S.init(M_TOK, 1024, G, bx);
        pg8::EpiMerged E{GA, GB, Merged};
        pg8::gemm_phase<pg8::EpiMerged, pg8::StaticOrder, true, true>(lds, g, S, E);
    }
    SEAM(4);

    if (IN(5)) {
        pg8::Gemm g{Merged, Wout_t, M_TOK, 1024, 1024}; pg8::StaticOrder S; S.init(M_TOK, 1024, G, bx);
        pg8::EpiResid E{x, out, modf + 2 * 1024};
        pg8::gemm_phase<pg8::EpiResid, pg8::StaticOrder, true, true>(lds, g, S, E);
    }
    SEAM(5);

    if (IN(6)) {
        const int tid = fresh_tid(), lane = tid & 63, wave = __builtin_amdgcn_readfirstlane(tid >> 6);
        LAS float* Av = (LAS float*)lds; LAS float* Bv = Av + 1024;
        for (int chk = bx; chk < 256; chk += G) {
            const int b = chk >> 6;
            for (int c = tid; c < 1024; c += 512) { Av[c] = norm_ffn_g[c] * (1.f + modf[b * N_MOD6 + 4 * 1024 + c]); Bv[c] = modf[b * N_MOD6 + 3 * 1024 + c]; }
            __syncthreads();
            for (int i = 0; i < 8; ++i) { const size_t row = (size_t)chk * 64 + wave * 8 + i; rms_row<true>(out + row * 1024, Av, Bv, H2 + row * 1024, lane); }
            __syncthreads();
        }
    }
    SEAM(6);

    if (IN(7)) {
        pg8::Gemm g{H2, Wgu_t, M_TOK, 2 * FFN_H, 1024}; pg8::StaticOrder S; S.init(M_TOK, 2 * FFN_H, G, bx);
        pg8::EpiSwiglu E{HF};
        pg8::gemm_phase<pg8::EpiSwiglu, pg8::StaticOrder, true, true>(lds, g, S, E);
    }
    SEAM(7);

    if (IN(8)) {
        pg8::Gemm g{HF, Wd_t, M_TOK, 1024, FFN_H}; pg8::StaticOrder S; S.init(M_TOK, 1024, G, bx);
        pg8::EpiResid E{out, out, modf + 5 * 1024};
        pg8::gemm_phase<pg8::EpiResid, pg8::StaticOrder, true, true>(lds, g, S, E);
    }
    SEAM(8);

    if (IN(9)) {
        const int tid = fresh_tid(), lane = tid & 63, wave = __builtin_amdgcn_readfirstlane(tid >> 6);
        LAS float* Av = (LAS float*)lds;
        for (int c = tid; c < 1024; c += 512) Av[c] = norm_final_g[c];
        __syncthreads();
        for (int chk = bx; chk < 256; chk += G)
            for (int i = 0; i < 8; ++i) { const size_t row = (size_t)chk * 64 + wave * 8 + i; rms_row<false>(out + row * 1024, Av, nullptr, out + row * 1024, lane); }
    }
#undef IN
#undef SEAM
}

extern "C" void kernel_launch(void* const* d_in, const int* in_sizes, int n_in, void* d_out, int out_size, void* d_ws, size_t ws_size, hipStream_t stream) {
    static int grid = 0;
    if (grid == 0) {
        if (n_in != 18 || out_size != M_TOK * D_MODEL || ws_size < WS_END) { fprintf(stderr, "kernel_launch: unexpected problem shape (n_in %d, out %d, ws %zu)\n", n_in, out_size, ws_size); grid = -1; return; }
        int dev = 0, cus = 0, per_cu = 0;
        (void)hipGetDevice(&dev);
        (void)hipDeviceGetAttribute(&cus, hipDeviceAttributeMultiprocessorCount, dev);
        if (hipFuncSetAttribute((const void*)fwd_megakernel, hipFuncAttributeMaxDynamicSharedMemorySize, LDS_BYTES) != hipSuccess) { fprintf(stderr, "kernel_launch: hipFuncSetAttribute failed\n"); grid = -1; return; }
        if (hipOccupancyMaxActiveBlocksPerMultiprocessor(&per_cu, (const void*)fwd_megakernel, 512, LDS_BYTES) != hipSuccess || per_cu < 1) per_cu = 1;
        (void)hipGetLastError();
        grid = cus * per_cu; if (grid > 256) grid = 256; if (grid < 1) grid = 256;
    }
    if (grid < 0) return;
    (void)hipMemsetAsync((unsigned char*)d_ws + WS_CTL, 0, 16384, stream);
    Args a{};
    for (int i = 0; i < 18; ++i) a.in[i] = (const float*)d_in[i];
    a.out = (float*)d_out; a.ws = (unsigned char*)d_ws;
#if MK_N_LAUNCHES == 1
    a.ph_lo = 0; a.ph_hi = NPHASE;
    void* kargs[] = {&a};
    hipError_t e = hipLaunchCooperativeKernel((const void*)fwd_megakernel, dim3(grid), dim3(512), kargs, LDS_BYTES, stream);
    if (e != hipSuccess) fprintf(stderr, "cooperative launch failed: %s (grid %d)\n", hipGetErrorString(e), grid);
#else
    for (int p = 0; p < NPHASE; ++p) {
        a.ph_lo = p; a.ph_hi = p + 1;
        hipLaunchKernelGGL(fwd_megakernel, dim3(grid), dim3(512), LDS_BYTES, stream, a);
    }
#endif
}
```
